# Optimizing an MI355X kernel written in HIP

```python
import math
import jax
import jax.numpy as jnp
from jax import lax
import numpy as np

D_MODEL = 2048
BATCH = 2
SEQ = 16384
DEPTH = 4
DEC_BATCH = 1
DEC_SEQ = 16384
PAST_LEN = 128

N_META = 16
N_MIXERS = 4
GROUP_W = D_MODEL // N_MIXERS
DA_HEADS = 4
DA_HD = GROUP_W // (2 * DA_HEADS)
ROT_DIM = DA_HD // 4
ROPE_THETA = 500000.0
Q_BLOCK = 128
HY_CH = GROUP_W
HY_BANDS = 16
HY_EMB = 1 + 2 * HY_BANDS
HY_FFN = 64
HY_SHIFT = 0.05
HG_HEADS = 4
HG_DK = GROUP_W // HG_HEADS
HG_DV = GROUP_W // HG_HEADS
GD_HEADS = 4
GD_DK = GROUP_W // GD_HEADS
GD_DV = GROUP_W // GD_HEADS
CHUNK = 64
PAD_FRONT = (-N_META) % CHUNK
SHORT_CONV = 3
D_FF = 5632
COLS_A = 3 * GROUP_W
COLS_B = 3 * GROUP_W
COLS_C = 5 * GROUP_W
COLS_D = 4 * GROUP_W + 4 * GD_HEADS
D_IN = COLS_A + COLS_B + COLS_C + COLS_D
ALPHA = (2.0 * DEPTH) ** 0.25
BETA_INIT = (8.0 * DEPTH) ** -0.25
LN_EPS = 1e-5
RMS_EPS = 1e-6
F32 = jnp.float32

kernel_name = 'hybrid_bidir_encoder_trunk'


def layer_norm(x, g, b):
    xf = x.astype(F32)
    mu = jnp.mean(xf, axis=-1, keepdims=True)
    var = jnp.mean(jnp.square(xf - mu), axis=-1, keepdims=True)
    return ((xf - mu) * lax.rsqrt(var + LN_EPS) * g.astype(F32) + b.astype(F32)).astype(x.dtype)


def rms_norm(x, g):
    xf = x.astype(F32)
    return (xf * lax.rsqrt(jnp.mean(xf * xf, axis=-1, keepdims=True) + RMS_EPS) * g.astype(F32)).astype(x.dtype)


def l2norm(x):
    return x * lax.rsqrt(jnp.sum(x * x, axis=-1, keepdims=True) + 1e-6)


def centred_conv(x, w, b=None):
    K = w.shape[0]
    r = K // 2
    L = x.shape[1]
    xp = jnp.pad(x, ((0, 0), (r, r), (0, 0)))
    y = xp[:, 0:L] * w[0]
    for j in range(1, K):
        y = y + xp[:, j:j + L] * w[j]
    if b is not None:
        y = y + b
    return y


def rotary(x, pos):
    half = ROT_DIM // 2
    inv = 1.0 / (ROPE_THETA ** (jnp.arange(half, dtype=F32) / half))
    ang = pos.astype(F32)[:, None] * inv[None]
    cos = jnp.cos(ang)[None, :, None, :]
    sin = jnp.sin(ang)[None, :, None, :]
    xr = x[..., :ROT_DIM].astype(F32)
    x1, x2 = xr[..., :half], xr[..., half:]
    rot = jnp.concatenate([x1 * cos - x2 * sin, x2 * cos + x1 * sin], axis=-1)
    return jnp.concatenate([rot.astype(x.dtype), x[..., ROT_DIM:]], axis=-1)


def pad_front(a):
    return jnp.pad(a, ((0, 0), (PAD_FRONT, 0)) + ((0, 0),) * (a.ndim - 2))


def stack_dirs(a_fwd, a_bwd):
    return jnp.concatenate([pad_front(a_fwd), jnp.flip(pad_front(a_bwd), axis=1)], axis=0)


def merge_dirs(o, B):
    return (o[:B] + jnp.flip(o[B:], axis=1))[:, PAD_FRONT:]


def diff_attn_mixer(pa, pos, l, lam_q1, lam_k1, lam_q2, lam_k2, norm_g):
    B, L, _ = pa.shape
    q, k, v = jnp.split(pa, 3, axis=-1)
    q = rotary(q.reshape(B, L, 2 * DA_HEADS, DA_HD), pos).reshape(B, L, DA_HEADS, 2, DA_HD)
    k = rotary(k.reshape(B, L, 2 * DA_HEADS, DA_HD), pos).reshape(B, L, DA_HEADS, 2, DA_HD)
    v = v.reshape(B, L, DA_HEADS, 2 * DA_HD)
    lam_init = 0.8 - 0.6 * math.exp(-0.3 * l)
    lam = (jnp.exp(jnp.sum(lam_q1.astype(F32) * lam_k1.astype(F32)))
           - jnp.exp(jnp.sum(lam_q2.astype(F32) * lam_k2.astype(F32))) + lam_init)
    scale = DA_HD ** -0.5
    nb = -(-L // Q_BLOCK)
    qp = jnp.pad(q, ((0, 0), (0, nb * Q_BLOCK - L), (0, 0), (0, 0), (0, 0)))
    qb = jnp.moveaxis(qp.reshape(B, nb, Q_BLOCK, DA_HEADS, 2, DA_HD), 1, 0)

    def block(qblk):
        s = jnp.einsum('bqhmd,bkhmd->bhmqk', qblk, k, preferred_element_type=F32) * scale
        prob = jax.nn.softmax(s, axis=-1)
        a = prob[:, :, 0] - lam * prob[:, :, 1]
        return jnp.einsum('bhqk,bkhe->bqhe', a.astype(v.dtype), v, preferred_element_type=F32)

    o = jnp.moveaxis(lax.map(block, qb), 0, 1).reshape(B, nb * Q_BLOCK, DA_HEADS, 2 * DA_HD)[:, :L]
    o = rms_norm(o, norm_g) * (1.0 - lam_init)
    return o.reshape(B, L, GROUP_W)


def hyena_filters(L, w1, b1, f1, w2, b2, f2, w3, decay):
    t = jnp.linspace(0.0, 1.0, L, dtype=F32)[:, None]
    bands = jnp.linspace(1e-4, HY_BANDS - 1, HY_BANDS, dtype=F32)
    ang = (2.0 * math.pi / L) * jnp.arange(L, dtype=F32)[:, None] * bands[None]
    z = jnp.concatenate([t, jnp.cos(ang), -jnp.sin(ang)], axis=-1)
    hid = jnp.sin(f1.astype(F32) * (z @ w1.astype(F32) + b1.astype(F32)))
    hid = jnp.sin(f2.astype(F32) * (hid @ w2.astype(F32) + b2.astype(F32)))
    filt = (hid @ w3.astype(F32)).reshape(L, 2, HY_CH)
    window = jnp.exp(-t[:, :, None] * jnp.abs(decay.astype(F32))[None]) + HY_SHIFT
    filt = filt * window
    filt = filt / (jnp.sum(jnp.abs(filt), axis=(0, 1)) + 1e-6)
    return filt[:, 0], filt[:, 1]


def long_conv(u, hf, hb, d_skip):
    L = u.shape[1]
    kern = jnp.concatenate([hf, jnp.zeros((1, hf.shape[1]), F32), jnp.flip(hb[1:], axis=0)], axis=0)
    uf = jnp.fft.rfft(u, n=2 * L, axis=1)
    kf = jnp.fft.rfft(kern, n=2 * L, axis=0)
    y = jnp.fft.irfft(uf * kf[None], n=2 * L, axis=1)[:, :L]
    return y + u * d_skip.astype(F32)


def hyena_mixer(pb, conv_w, conv_b, w1, b1, f1, w2, b2, f2, w3, decay, d_skip):
    B, L, _ = pb.shape
    u = centred_conv(pb, conv_w, conv_b).astype(F32)
    x0, x1, v = jnp.split(u, 3, axis=-1)
    hf, hb = hyena_filters(L, w1, b1, f1, w2, b2, f2, w3, decay)
    return x0 * long_conv(x1 * v, hf, hb, d_skip)


def gla_chunked(q, k, v, g):
    Bx, T, H, dk = q.shape
    dv = v.shape[-1]
    N = T // CHUNK

    def chunk(a):
        return a.astype(F32).reshape(Bx, N, CHUNK, H, a.shape[-1]).transpose(1, 0, 3, 2, 4)

    qc, kc, vc = chunk(q), chunk(k), chunk(v)
    bc = jnp.cumsum(chunk(g), axis=3)
    causal = jnp.tril(jnp.ones((CHUNK, CHUNK), dtype=bool))

    def step(S, inp):
        qi, ki, vi, bi = inp
        o_inter = jnp.einsum('bhcd,bhde->bhce', qi * jnp.exp(bi), S)
        diff = bi[:, :, :, None, :] - bi[:, :, None, :, :]
        dec = jnp.exp(jnp.where(causal[:, :, None], diff, -jnp.inf))
        A = jnp.einsum('bhid,bhjd,bhijd->bhij', qi, ki, dec)
        o = o_inter + A @ vi
        bl = bi[:, :, -1]
        S = jnp.exp(bl)[..., None] * S + jnp.einsum('bhcd,bhce->bhde', ki * jnp.exp(bl[:, :, None] - bi), vi)
        return S, o

    _, o = lax.scan(step, jnp.zeros((Bx, H, dk, dv), F32), (qc, kc, vc, bc))
    return o.transpose(1, 0, 3, 2, 4).reshape(Bx, T, H, dv)


def hgrn2_mixer(pc, lb, norm_g):
    B, L, _ = pc.shape
    q, ff, fb, i, gate = jnp.split(pc, 5, axis=-1)

    def heads(a):
        return a.reshape(B, L, HG_HEADS, -1)

    q = jax.nn.silu(q.astype(F32)) * HG_DK ** -0.5
    lb = lb.astype(F32)
    g_f = jnp.log(lb[0] + (1.0 - lb[0]) * jax.nn.sigmoid(ff.astype(F32)))
    g_b = jnp.log(lb[1] + (1.0 - lb[1]) * jax.nn.sigmoid(fb.astype(F32)))
    k_f = 1.0 - jnp.exp(g_f)
    k_b = 1.0 - jnp.exp(g_b)
    qh, ih = heads(q), heads(i)
    o = gla_chunked(stack_dirs(qh, qh), stack_dirs(heads(k_f), heads(k_b)),
                    stack_dirs(ih, ih), stack_dirs(heads(g_f), heads(g_b)))
    o = merge_dirs(o, B)
    o = rms_norm(o, norm_g) * jax.nn.silu(heads(gate).astype(F32))
    return o.reshape(B, L, GROUP_W)


def gdn_chunked(q, k, v, beta, g):
    Bx, T, H, dk = q.shape
    dv = v.shape[-1]
    N = T // CHUNK

    def chunk(a):
        return a.astype(F32).reshape(Bx, N, CHUNK, H, a.shape[-1]).transpose(0, 3, 1, 2, 4)

    qc, kc, vc = chunk(q), chunk(k), chunk(v)
    betac = chunk(beta[..., None])[..., 0]
    b = jnp.cumsum(chunk(g[..., None])[..., 0], axis=-1)
    incl = jnp.tril(jnp.ones((CHUNK, CHUNK), dtype=bool))
    strict = jnp.tril(jnp.ones((CHUNK, CHUNK), dtype=bool), -1)
    decay = jnp.exp(jnp.where(incl, b[..., :, None] - b[..., None, :], -jnp.inf))
    kb = kc * betac[..., None]
    M = jnp.where(strict, jnp.einsum('bhnid,bhnjd->bhnij', kb, kc) * decay, 0.0)
    eye = jnp.eye(CHUNK, dtype=F32)
    rhs = jnp.concatenate([vc * betac[..., None], kb * jnp.exp(b)[..., None]], axis=-1)
    sol = lax.linalg.triangular_solve(M + eye, rhs, left_side=True, lower=True, unit_diagonal=True)
    u, w = sol[..., :dv], sol[..., dv:]
    qk = jnp.einsum('bhnid,bhnjd->bhnij', qc, kc) * decay
    qe = qc * jnp.exp(b)[..., None]
    kd = kc * jnp.exp(b[..., -1:] - b)[..., None]
    blast = jnp.exp(b[..., -1])
    xs = tuple(jnp.moveaxis(a, 2, 0) for a in (u, w, qk, qe, kd, blast))

    def step(S, inp):
        u_i, w_i, qk_i, qe_i, kd_i, bl_i = inp
        vnew = u_i - w_i @ S
        o = qe_i @ S + qk_i @ vnew
        S = S * bl_i[..., None, None] + jnp.swapaxes(kd_i, -1, -2) @ vnew
        return S, o

    _, o = lax.scan(step, jnp.zeros((Bx, H, dk, dv), F32), xs)
    return o.transpose(1, 0, 3, 2, 4).reshape(Bx, T, H, dv)


def gdn_mixer(pd, conv_w, a_log, dt_bias, norm_g):
    B, L, _ = pd.shape
    W, H = GROUP_W, GD_HEADS
    qkv, z, bf, bb, af, ab = jnp.split(pd, [3 * W, 4 * W, 4 * W + H, 4 * W + 2 * H, 4 * W + 3 * H], axis=-1)
    qkv = jax.nn.silu(centred_conv(qkv, conv_w).astype(F32))
    q, k, v = jnp.split(qkv, 3, axis=-1)
    q = l2norm(q.reshape(B, L, H, GD_DK)) * GD_DK ** -0.5
    k = l2norm(k.reshape(B, L, H, GD_DK))
    v = v.reshape(B, L, H, GD_DV)
    a_log = a_log.astype(F32)
    dt_bias = dt_bias.astype(F32)
    beta_f = jax.nn.sigmoid(bf.astype(F32))
    beta_b = jax.nn.sigmoid(bb.astype(F32))
    g_f = -jnp.exp(a_log[0]) * jax.nn.softplus(af.astype(F32) + dt_bias[0])
    g_b = -jnp.exp(a_log[1]) * jax.nn.softplus(ab.astype(F32) + dt_bias[1])
    o = gdn_chunked(stack_dirs(q, q), stack_dirs(k, k), stack_dirs(v, v),
                    stack_dirs(beta_f, beta_b), stack_dirs(g_f, g_b))
    o = merge_dirs(o, B)
    o = rms_norm(o, norm_g) * jax.nn.silu(z.reshape(B, L, H, GD_DV).astype(F32))
    return o.reshape(B, L, GROUP_W)


def mixers(h, l, pos, lb, p):
    proj = h @ p['w_in'][l]
    pa, pb, pc, pd = jnp.split(proj, [COLS_A, COLS_A + COLS_B, COLS_A + COLS_B + COLS_C], axis=-1)
    oa = diff_attn_mixer(pa, pos, l, p['lam_q1'][l], p['lam_k1'][l], p['lam_q2'][l], p['lam_k2'][l],
                         p['attn_norm_g'][l])
    ob = hyena_mixer(pb, p['hy_conv_w'][l], p['hy_conv_b'][l], p['hy_w1'][l], p['hy_b1'][l], p['hy_f1'][l],
                     p['hy_w2'][l], p['hy_b2'][l], p['hy_f2'][l], p['hy_w3'][l], p['hy_decay'][l], p['hy_d'][l])
    oc = hgrn2_mixer(pc, lb, p['hg_norm_g'][l])
    od = gdn_mixer(pd, p['gdn_conv_w'][l], p['gdn_a_log'][l], p['gdn_dt_bias'][l], p['gdn_norm_g'][l])
    o = jnp.concatenate([oa, ob, oc, od], axis=-1).astype(h.dtype)
    return o @ p['w_out'][l]


def conv_ffn(x, w_up, conv_w, conv_b, w_down):
    u = centred_conv(x @ w_up, conv_w, conv_b)
    g, up = jnp.split(u, 2, axis=-1)
    return (jax.nn.silu(g) * up) @ w_down


def trunk(x, p):
    B, S, _ = x.shape
    L = S + N_META
    meta = jnp.broadcast_to(p['meta'][None].astype(x.dtype), (B, N_META, D_MODEL))
    h = layer_norm(jnp.concatenate([meta, x], axis=1), p['emb_ln_g'], p['emb_ln_b'])
    pos = jnp.arange(L)
    sm = jax.nn.softmax(p['hg_lb'].astype(F32), axis=0)
    lb_all = jnp.cumsum(sm, axis=0) - sm[0]
    for l in range(DEPTH):
        m = mixers(h, l, pos, lb_all[l], p)
        h = layer_norm(ALPHA * h + m, p['ln1_g'][l], p['ln1_b'][l])
        f = conv_ffn(h, p['w_up'][l], p['ffn_conv_w'][l], p['ffn_conv_b'][l], p['w_down'][l])
        h = layer_norm(ALPHA * h + f, p['ln2_g'][l], p['ln2_b'][l])
    return h[:, N_META:]


def setup_inputs(seed: int = 0) -> dict:
    key = jax.random.key(seed)
    ks = iter(jax.random.split(key, 40))

    def nrm(shape, scale):
        return jax.random.normal(next(ks), shape, F32) * scale

    def gain(shape):
        return 1.0 + nrm(shape, 0.02)

    x_prompt = nrm((BATCH, SEQ, D_MODEL), 1.0)
    x_sample = nrm((DEC_BATCH, DEC_SEQ, D_MODEL), 1.0)
    meta = nrm((N_META, D_MODEL), 1.0)
    emb_ln_g = gain((D_MODEL,))
    emb_ln_b = nrm((D_MODEL,), 0.02)
    w_in = nrm((DEPTH, D_MODEL, D_IN), D_MODEL ** -0.5)
    lam_q1 = nrm((DEPTH, DA_HD), 0.1)
    lam_k1 = nrm((DEPTH, DA_HD), 0.1)
    lam_q2 = nrm((DEPTH, DA_HD), 0.1)
    lam_k2 = nrm((DEPTH, DA_HD), 0.1)
    attn_norm_g = gain((DEPTH, 2 * DA_HD))
    hy_conv_w = nrm((DEPTH, SHORT_CONV, COLS_B), SHORT_CONV ** -0.5)
    hy_conv_b = nrm((DEPTH, COLS_B), 0.02)
    hy_w1 = nrm((DEPTH, HY_EMB, HY_FFN), HY_EMB ** -0.5)
    hy_b1 = nrm((DEPTH, HY_FFN), 0.1)
    hy_f1 = gain((DEPTH, HY_FFN))
    hy_w2 = nrm((DEPTH, HY_FFN, HY_FFN), HY_FFN ** -0.5)
    hy_b2 = nrm((DEPTH, HY_FFN), 0.1)
    hy_f2 = gain((DEPTH, HY_FFN))
    hy_w3 = nrm((DEPTH, HY_FFN, 2 * HY_CH), HY_FFN ** -0.5)
    rates = jnp.abs(jnp.linspace(math.log(1e-2) / 1.5, math.log(1e-2) / 0.3, HY_CH, dtype=F32))
    hy_decay = rates * (1.0 + nrm((DEPTH, 2, HY_CH), 0.05))
    hy_d = nrm((DEPTH, HY_CH), 1.0)
    hg_lb = nrm((DEPTH, 2, GROUP_W), 0.1)
    hg_norm_g = gain((DEPTH, HG_DV))
    gdn_conv_w = nrm((DEPTH, SHORT_CONV, 3 * GROUP_W), SHORT_CONV ** -0.5)
    gdn_a_log = jnp.log(jax.random.uniform(next(ks), (DEPTH, 2, GD_HEADS), F32, 1.0, 16.0))
    dt = jnp.exp(jax.random.uniform(next(ks), (DEPTH, 2, GD_HEADS), F32, math.log(1e-3), math.log(1e-1)))
    gdn_dt_bias = dt + jnp.log(-jnp.expm1(-dt))
    gdn_norm_g = gain((DEPTH, GD_DV))
    w_out = nrm((DEPTH, D_MODEL, D_MODEL), BETA_INIT * D_MODEL ** -0.5)
    ln1_g = gain((DEPTH, D_MODEL))
    ln1_b = nrm((DEPTH, D_MODEL), 0.02)
    w_up = nrm((DEPTH, D_MODEL, 2 * D_FF), D_MODEL ** -0.5)
    ffn_conv_w = nrm((DEPTH, SHORT_CONV, 2 * D_FF), SHORT_CONV ** -0.5)
    ffn_conv_b = nrm((DEPTH, 2 * D_FF), 0.02)
    w_down = nrm((DEPTH, D_FF, D_MODEL), BETA_INIT * D_FF ** -0.5)
    ln2_g = gain((DEPTH, D_MODEL))
    ln2_b = nrm((DEPTH, D_MODEL), 0.02)
    return {'x_prompt': x_prompt, 'x_sample': x_sample, 'meta': meta, 'emb_ln_g': emb_ln_g,
            'emb_ln_b': emb_ln_b, 'w_in': w_in, 'lam_q1': lam_q1, 'lam_k1': lam_k1, 'lam_q2': lam_q2,
            'lam_k2': lam_k2, 'attn_norm_g': attn_norm_g, 'hy_conv_w': hy_conv_w, 'hy_conv_b': hy_conv_b,
            'hy_w1': hy_w1, 'hy_b1': hy_b1, 'hy_f1': hy_f1, 'hy_w2': hy_w2, 'hy_b2': hy_b2, 'hy_f2': hy_f2,
            'hy_w3': hy_w3, 'hy_decay': hy_decay, 'hy_d': hy_d, 'hg_lb': hg_lb, 'hg_norm_g': hg_norm_g,
            'gdn_conv_w': gdn_conv_w, 'gdn_a_log': gdn_a_log, 'gdn_dt_bias': gdn_dt_bias,
            'gdn_norm_g': gdn_norm_g, 'w_out': w_out, 'ln1_g': ln1_g, 'ln1_b': ln1_b, 'w_up': w_up,
            'ffn_conv_w': ffn_conv_w, 'ffn_conv_b': ffn_conv_b, 'w_down': w_down, 'ln2_g': ln2_g,
            'ln2_b': ln2_b}


def reference(x_prompt, x_sample, meta, emb_ln_g, emb_ln_b, w_in, lam_q1, lam_k1, lam_q2, lam_k2,
              attn_norm_g, hy_conv_w, hy_conv_b, hy_w1, hy_b1, hy_f1, hy_w2, hy_b2, hy_f2, hy_w3,
              hy_decay, hy_d, hg_lb, hg_norm_g, gdn_conv_w, gdn_a_log, gdn_dt_bias, gdn_norm_g,
              w_out, ln1_g, ln1_b, w_up, ffn_conv_w, ffn_conv_b, w_down, ln2_g, ln2_b):
    p = dict(meta=meta, emb_ln_g=emb_ln_g, emb_ln_b=emb_ln_b, w_in=w_in, lam_q1=lam_q1, lam_k1=lam_k1,
             lam_q2=lam_q2, lam_k2=lam_k2, attn_norm_g=attn_norm_g, hy_conv_w=hy_conv_w,
             hy_conv_b=hy_conv_b, hy_w1=hy_w1, hy_b1=hy_b1, hy_f1=hy_f1, hy_w2=hy_w2, hy_b2=hy_b2,
             hy_f2=hy_f2, hy_w3=hy_w3, hy_decay=hy_decay, hy_d=hy_d, hg_lb=hg_lb, hg_norm_g=hg_norm_g,
             gdn_conv_w=gdn_conv_w, gdn_a_log=gdn_a_log, gdn_dt_bias=gdn_dt_bias, gdn_norm_g=gdn_norm_g,
             w_out=w_out, ln1_g=ln1_g, ln1_b=ln1_b, w_up=w_up, ffn_conv_w=ffn_conv_w,
             ffn_conv_b=ffn_conv_b, w_down=w_down, ln2_g=ln2_g, ln2_b=ln2_b)
    y_prompt = trunk(x_prompt, p)
    y_sample = trunk(x_sample, p)
    return (y_prompt, y_sample)
```

```cpp
#ifdef HIPEMU
#include "hipemu.h"
#define LAS
#define WAITCNT_VM(n)
#define WAITCNT_LGKM(n)
#define WAVE_SYNC() hipemu::wave_rendezvous()
#define LAUNCH HIPEMU_LAUNCH
#define DYN_LDS(name) unsigned char* name = hipemu::cur->blk->lds
#define OPAQUE(v)
#define OPAQUE_S(v)
#define MEMFENCE()
#define WAITCNT_ALL()
#define FENCE_RELEASE_AGENT() __atomic_thread_fence(__ATOMIC_SEQ_CST)
#define FENCE_ACQUIRE_AGENT() __atomic_thread_fence(__ATOMIC_SEQ_CST)
#else
#include <hip/hip_runtime.h>
#include <cstdio>
#include <cstdint>
#define LAS __attribute__((address_space(3)))
#define WAITCNT_VM(n) asm volatile("s_waitcnt vmcnt(" #n ")" ::: "memory")
#define WAITCNT_LGKM(n) asm volatile("s_waitcnt lgkmcnt(" #n ")" ::: "memory")
#define WAVE_SYNC() __builtin_amdgcn_wave_barrier()
#define LAUNCH(kernel, grid, block, ldsb, stream, ...) hipLaunchKernelGGL(kernel, grid, block, ldsb, stream, __VA_ARGS__)
#define OPAQUE(v) asm volatile("" : "+v"(v))
#define MEMFENCE() asm volatile("" ::: "memory")
#define OPAQUE_S(v) asm volatile("" : "+s"(v))
#define WAITCNT_ALL() __builtin_amdgcn_s_waitcnt(0)
#define FENCE_RELEASE_AGENT() __builtin_amdgcn_fence(__ATOMIC_RELEASE, "agent")
#define FENCE_ACQUIRE_AGENT() __builtin_amdgcn_fence(__ATOMIC_ACQUIRE, "agent")
#define DYN_LDS(name) extern __shared__ __attribute__((aligned(16))) unsigned char name##_raw[]; LAS unsigned char* name = (LAS unsigned char*)name##_raw
#endif
#include <cmath>

#ifdef HIPEMU
#ifndef CFG_SEQ
#define CFG_SEQ 256
#endif
#ifndef CFG_DEPTH
#define CFG_DEPTH 1
#endif
#ifndef CFG_DFF
#define CFG_DFF 512
#endif
constexpr int SEQ = CFG_SEQ, NSEQ = 2, DEPTH = CFG_DEPTH, DFF = CFG_DFF;
#else
constexpr int SEQ = 16384, NSEQ = 3, DEPTH = 4, DFF = 5632;
#endif
constexpr int DM = 2048, NMETA = 16, L = SEQ + NMETA, LP = (L + 255) / 256 * 256;
constexpr int DIN = 7696, PP = 7936;
static_assert(SEQ % 256 == 0, "full 256-row GEMM tiles cover the non-meta tokens; the 16 remaining rows go through tail_gemm");
constexpr int NCH = (L + 63) / 64;
constexpr int NB128 = SEQ / 128;
constexpr float LN_EPS = 1e-5f, RMS_EPS = 1e-6f;
constexpr int NT = 512;
constexpr int LDS_BYTES = 160 * 1024;
constexpr int CA_Q = 0, CA_K = 512, CA_V = 1024, CB_X0 = 1536, CB_X1 = 2048, CB_V = 2560;
constexpr int CC_Q = 3072, CC_FF = 3584, CC_FB = 4096, CC_I = 4608, CC_G = 5120;
constexpr int CD_Q = 5632, CD_K = 6144, CD_V = 6656, CD_Z = 7168, CD_BF = 7680, CD_BB = 7684, CD_AF = 7688, CD_AB = 7692;
enum { I_XP = 0, I_XS, I_META, I_EMBG, I_EMBB, I_WIN, I_LQ1, I_LK1, I_LQ2, I_LK2, I_ANG, I_HCW, I_HCB, I_HW1, I_HB1, I_HF1, I_HW2, I_HB2, I_HF2, I_HW3,
       I_HDEC, I_HD, I_HGLB, I_HGNG, I_GCW, I_GALOG, I_GDT, I_GNG, I_WOUT, I_LN1G, I_LN1B, I_WUP, I_FCW, I_FCB, I_WDOWN, I_LN2G, I_LN2B, N_IN };

typedef unsigned short bf16_t;
typedef short bf16x8 __attribute__((ext_vector_type(8)));
typedef float f32x4 __attribute__((ext_vector_type(4)));
typedef float f32x2_t __attribute__((ext_vector_type(2)));
typedef float f32x16 __attribute__((ext_vector_type(16)));
typedef unsigned u32x4 __attribute__((ext_vector_type(4)));
typedef unsigned u32x2 __attribute__((ext_vector_type(2)));

__host__ __device__ constexpr float alpha_of_depth() { return DEPTH == 4 ? 1.6817928305074290f : DEPTH == 1 ? 1.1892071150027210f : DEPTH == 2 ? 1.4142135623730951f : 1.5650845800732873f; }

constexpr size_t al256(size_t x) { return (x + 255) / 256 * 256; }
constexpr size_t OFF_CTL = 0, SZ_CTL = 1u << 20;
constexpr int CW_QUEUE = 8192, CW_QUEUE2 = 11264, CTL_ZERO_BYTES = 65536;
constexpr size_t OFF_HMETA = OFF_CTL + SZ_CTL, SZ_HMETA = al256((size_t)NSEQ * NMETA * DM * 4);
constexpr size_t OFF_STATS = OFF_HMETA + SZ_HMETA, SZ_STATS = al256((size_t)NSEQ * L * 2 * 4);
constexpr size_t OFF_ROPE = OFF_STATS + SZ_STATS, SZ_ROPE = al256((size_t)L * 16 * 4);
constexpr size_t OFF_WIN = OFF_ROPE + SZ_ROPE, SZ_WIN = (size_t)PP * DM * 2;
constexpr size_t OFF_WOUT = OFF_WIN + SZ_WIN, SZ_WOUT = (size_t)DM * DM * 2;
constexpr size_t OFF_WUP = OFF_WOUT + SZ_WOUT, SZ_WUP = (size_t)2 * DFF * DM * 2;
constexpr size_t OFF_WDOWN = OFF_WUP + SZ_WUP, SZ_WDOWN = (size_t)DM * DFF * 2;
constexpr size_t OFF_HBF = OFF_WDOWN + SZ_WDOWN, SZ_HBF = (size_t)NSEQ * LP * DM * 2;
constexpr size_t OFF_OBUF = OFF_HBF + SZ_HBF, SZ_OBUF = SZ_HBF;
constexpr int HRP = (2 * L + 4096 + 63) / 64 * 64, HOFF = L + 2048;
constexpr size_t OFF_HR = OFF_OBUF + SZ_OBUF, SZ_HR = al256((size_t)512 * HRP * 2);
constexpr size_t OFF_HPART = OFF_HR + SZ_HR, SZ_HPART = al256((size_t)1024 * 1024 * 4);
constexpr size_t OFF_UT = OFF_HPART + SZ_HPART, SZ_UT = (size_t)512 * LP * 2;
constexpr size_t OFF_X0T = OFF_UT + SZ_UT, SZ_X0T = SZ_UT;
constexpr size_t OFF_SEQ = OFF_X0T + SZ_X0T;
constexpr size_t OFF_PROJ = OFF_SEQ, SZ_PROJ = (size_t)LP * PP * 2;
constexpr size_t OFF_QR = OFF_PROJ + SZ_PROJ, SZ_QR = (size_t)8 * LP * 64 * 2;
constexpr size_t OFF_KR = OFF_QR + SZ_QR, SZ_KR = SZ_QR;
constexpr size_t OFF_VT = OFF_KR + SZ_KR, SZ_VT = (size_t)4 * 128 * LP * 2;
constexpr int HG_QT = 0, HG_A = 17408, HG_KT = HG_A + 9216, HG_VT = HG_KT + 18432, HG_D = HG_VT + 18432, HG_UNIT = HG_D + 512;
constexpr int GD_W = 0, GD_QE = 17408, GD_QK = GD_QE + 17408, GD_KDT = GD_QK + 9216, GD_UT = GD_KDT + 18432, GD_BL = GD_UT + 18432, GD_UNIT = GD_BL + 256;
constexpr size_t OFF_HGOPS = OFF_VT + SZ_VT, SZ_HGOPS = (size_t)NCH * 8 * HG_UNIT;
constexpr size_t OFF_GDOPS = OFF_HGOPS + SZ_HGOPS, SZ_GDOPS = (size_t)NCH * 8 * GD_UNIT;
constexpr size_t OFF_OSC = OFF_GDOPS + SZ_GDOPS, SZ_OSC1 = (size_t)LP * 512 * 4;
constexpr size_t OFF_AO0 = OFF_OSC + 4 * SZ_OSC1, SZ_AO0 = (size_t)2 * LP * 512 * 4;
constexpr size_t OFF_SEQ_END = OFF_AO0 + SZ_AO0;
constexpr size_t OFF_RAW = OFF_HGOPS;
static_assert((size_t)L * 1024 * 4 <= SZ_HGOPS + SZ_GDOPS, "raw filter overlay");
constexpr size_t OFF_U = OFF_SEQ, SZ_U = (size_t)LP * 2 * DFF * 2;
constexpr size_t OFF_ACT = OFF_U + SZ_U, SZ_ACT = (size_t)LP * DFF * 2;
constexpr size_t WS_NEED = (OFF_SEQ_END > OFF_ACT + SZ_ACT ? OFF_SEQ_END : OFF_ACT + SZ_ACT);

struct Params { const float* in[N_IN]; float* out; unsigned char* ws; };

__device__ __forceinline__ int otid() { int t = threadIdx.x; OPAQUE(t); return t; }
__device__ __forceinline__ float bf2f(bf16_t b) { return __uint_as_float(((unsigned)b) << 16); }
__device__ __forceinline__ unsigned f2bf(float f) { unsigned u = __float_as_uint(f); return (u + 0x7fffu + ((u >> 16) & 1u)) >> 16; }
__device__ __forceinline__ unsigned pk2(float lo, float hi) {
#ifdef HIPEMU
    return f2bf(lo) | (f2bf(hi) << 16);
#else
    unsigned r; asm volatile("v_cvt_pk_bf16_f32 %0, %1, %2" : "=v"(r) : "v"(lo), "v"(hi)); return r;
#endif
}
__device__ __forceinline__ float wave_sum(float v) {
#pragma unroll
    for (int o = 1; o < 64; o <<= 1) v += __shfl_xor(v, o);
    return v;
}
__device__ __forceinline__ void sincos2pi(float f, float* s, float* c) {
#ifdef HIPEMU
    *s = (float)sin(6.283185307179586476925 * (double)f); *c = (float)cos(6.283185307179586476925 * (double)f);
#else
    *s = sinpif(2.f * f); *c = cospif(2.f * f);
#endif
}
__device__ __forceinline__ float fexp2(float x) { return __builtin_amdgcn_exp2f(x); }
__device__ __forceinline__ float sigmoidf_(float x) { return 1.f / (1.f + __expf(-x)); }
__device__ __forceinline__ float siluf_(float x) { return x / (1.f + __expf(-x)); }
__device__ __forceinline__ float* hrow(const Params& p, int seq, int t) {
    return t < NMETA ? (float*)(p.ws + OFF_HMETA) + ((size_t)seq * NMETA + t) * DM : p.out + ((size_t)seq * SEQ + (t - NMETA)) * DM;
}
namespace pg8 {
#define PG8_LAS LAS
typedef unsigned short bf16_t;
typedef short bf16x8 __attribute__((ext_vector_type(8)));
typedef float f32x4 __attribute__((ext_vector_type(4)));
typedef unsigned u32x4 __attribute__((ext_vector_type(4)));
constexpr int BM = 256, BK = 64, HALF = 128, HTB = HALF * BK * 2  , STAGE_BYTES = 8 * HTB, NXCD = 8, WGM = 8;

__host__ __device__ __forceinline__ int lds_byte(int r, int c) { const int st = (r >> 4) * 2 + (c >> 5), rr = r & 15, cc = c & 31, ob = rr * 64 + cc * 2; return st * 1024 + (ob ^ (((ob >> 9) & 1) << 5)); }
__host__ __device__ __forceinline__ void stage_rc(int b, int& R, int& C) { const int st = b / 1024, sb = b % 1024, swz = sb ^ (((sb >> 9) & 1) << 5); R = (st >> 1) * 16 + swz / 64; C = (st & 1) * 32 + (swz % 64) / 2; }
__host__ __device__ __forceinline__ int perm32(int rho) { const int n = rho >> 4, i = rho & 15; return 8 * (i >> 2) + 4 * n + (i & 3); }

struct Unit { int pm, pn; };
struct Gemm { const bf16_t* A; const bf16_t* Bt; int M, N, K; };

struct StaticOrder {
    int nM, nN, nwg, G, c;
    __host__ __device__ void init(int M, int N, int G_, int c_) { nM = M / BM; nN = N / BM; nwg = nM * nN; G = G_; c = c_; }
    __host__ __device__ bool next(int i, Unit& u) const {
        const long L = (long)i * G + c; if (L >= nwg) return false;
        int wgid = (int)L; { const int q = nwg / NXCD, r = nwg % NXCD, xcd = wgid % NXCD, off = wgid / NXCD; wgid = (xcd < r ? xcd * (q + 1) : r * (q + 1) + (xcd - r) * q) + off; }
        const int nig = WGM * nN, gid = wgid / nig, fm = gid * WGM, gsz = (nM - fm) < WGM ? (nM - fm) : WGM;
        u.pm = fm + ((wgid % nig) % gsz); u.pn = (wgid % nig) / gsz; return true;
    }
    __device__ __forceinline__ void a_ready(const Unit&) const {}
    __device__ __forceinline__ void done(const Unit&) const {}
};


template <class Epi, class Sched, bool ALIGN_EPI = false, bool SP2 = false>
__device__ __forceinline__ void gemm_phase(PG8_LAS unsigned char* lds, const Gemm g, const Sched& S, const Epi& E) {
    const int tid = otid(), wid = __builtin_amdgcn_readfirstlane(tid >> 6), lane = tid & 63, wr = wid >> 2, wc = wid & 3, fr = lane & 15, fq = lane >> 4;
    const int K = g.K, nt = K / BK;
    unsigned voffA[2], voffB[2];
#pragma unroll
    for (int i = 0; i < 2; ++i) { int R, C; stage_rc(tid * 16 + i * 8192, R, C); const int Rb = Epi::PERM ? ((R & ~31) + perm32(R & 31)) : R;
        voffA[i] = (unsigned)(R * K + C) * 2u; voffB[i] = (unsigned)(Rb * K + C) * 2u; }
    const size_t kstep = (size_t)(BK * 2);
    const size_t hstep = (size_t)HALF * K * 2;
    const size_t tstep = 2 * hstep;
    const unsigned ldsw = (unsigned)wid * 1024u;
    const int aoff = lds_byte(wr * 64 + fr, fq * 8), boff = lds_byte(wc * 32 + fr, fq * 8);
#define PG8_SA(b, h) (((b) * 2 + (h)) * HTB)
#define PG8_SB(b, h) ((4 + (b) * 2 + (h)) * HTB)
#define PG8_STAGE(bufoff, gbase, voff) do { _Pragma("unroll") for (int _i = 0; _i < 2; ++_i) \
        __builtin_amdgcn_global_load_lds((const unsigned*)((const char*)(gbase) + (voff)[_i]), (PG8_LAS unsigned*)(lds + (bufoff) + ldsw + _i * 8192), 16, 0, 0); } while (0)
#define PG8_LDA(dst, b, h) do { _Pragma("unroll") for (int m = 0; m < 4; ++m) _Pragma("unroll") for (int k = 0; k < 2; ++k) dst[m][k] = *(const PG8_LAS bf16x8*)(lds + PG8_SA(b, h) + aoff + m * 2048 + k * 1024); } while (0)
#define PG8_LDB(dst, b, h) do { _Pragma("unroll") for (int n = 0; n < 2; ++n) _Pragma("unroll") for (int k = 0; k < 2; ++k) dst[n][k] = *(const PG8_LAS bf16x8*)(lds + PG8_SB(b, h) + boff + n * 2048 + k * 1024); } while (0)
#define PG8_MMA(ai, bj, At, Bt) do { __builtin_amdgcn_s_setprio(1); _Pragma("unroll") for (int m = 0; m < 4; ++m) _Pragma("unroll") for (int n = 0; n < 2; ++n) _Pragma("unroll") for (int k = 0; k < 2; ++k) \
        acc[ai][bj][m][n] = __builtin_amdgcn_mfma_f32_16x16x32_bf16(Bt[n][k], At[m][k], acc[ai][bj][m][n], 0, 0, 0); __builtin_amdgcn_s_setprio(0); } while (0)
#define PG8_WAIT_V(n) WAITCNT_VM(n)
#define PG8_WAIT_L(n) WAITCNT_LGKM(n)
#define PG8_BAR __builtin_amdgcn_s_barrier()
#define PG8_SCHED __builtin_amdgcn_sched_barrier(0)
    Unit cur, nxt; int ui = 0;
    if (!S.next(0, cur)) return;
    f32x4 acc[2][2][4][2];
#pragma unroll
    for (int a = 0; a < 2; ++a)
#pragma unroll
        for (int b = 0; b < 2; ++b)
#pragma unroll
            for (int m = 0; m < 4; ++m)
#pragma unroll
                for (int n = 0; n < 2; ++n) acc[a][b][m][n] = (f32x4){0.f, 0.f, 0.f, 0.f};
    bf16x8 At[4][2], B0[2][2], B1[2][2];
    const char* cA = (const char*)g.A + (size_t)cur.pm * tstep; const char* cB = (const char*)g.Bt + (size_t)cur.pn * tstep;
    S.a_ready(cur);
    if constexpr (SP2) {
        PG8_STAGE(PG8_SB(0, 0), cB, voffB); PG8_STAGE(PG8_SB(0, 1), cB + hstep, voffB); PG8_STAGE(PG8_SA(0, 0), cA, voffA); PG8_STAGE(PG8_SA(0, 1), cA + hstep, voffA);
        if (wr == 1) PG8_BAR;
        PG8_WAIT_V(2); PG8_BAR;
        PG8_STAGE(PG8_SB(1, 0), cB + kstep, voffB); PG8_STAGE(PG8_SA(1, 0), cA + kstep, voffA); PG8_STAGE(PG8_SB(1, 1), cB + hstep + kstep, voffB);
        PG8_WAIT_V(6); PG8_BAR;
    } else {
        PG8_STAGE(PG8_SB(0, 0), cB, voffB); PG8_STAGE(PG8_SA(0, 0), cA, voffA); PG8_STAGE(PG8_SB(0, 1), cB + hstep, voffB); PG8_STAGE(PG8_SA(0, 1), cA + hstep, voffA);
        if (wr == 1) PG8_BAR;
        PG8_WAIT_V(4); PG8_BAR;
        PG8_STAGE(PG8_SB(1, 0), cB + kstep, voffB); PG8_STAGE(PG8_SA(1, 0), cA + kstep, voffA); PG8_STAGE(PG8_SB(1, 1), cB + hstep + kstep, voffB);
        PG8_WAIT_V(6); PG8_BAR;
    }
    for (;;) {
        const bool has_next = S.next(ui + 1, nxt);
        const char* nA = has_next ? (const char*)g.A + (size_t)nxt.pm * tstep : cA; const char* nB = has_next ? (const char*)g.Bt + (size_t)nxt.pn * tstep : cB;
        for (int t = 0; t < nt; t += 2) {
            const bool last = (t == nt - 2);
            const char* a1 = cA + (size_t)(t + 1) * kstep;
            const char* a2 = last ? nA : cA + (size_t)(t + 2) * kstep; const char* b2 = last ? nB : cB + (size_t)(t + 2) * kstep;
            const char* a3 = a2 + kstep; const char* b3 = b2 + kstep;
            if (last && has_next) S.a_ready(nxt);
            if constexpr (SP2) {
            PG8_LDB(B0, 0, 0); PG8_LDB(B1, 0, 1); PG8_SCHED; PG8_LDA(At, 0, 0); PG8_STAGE(PG8_SA(1, 1), a1 + hstep, voffA);
            PG8_WAIT_V(8); PG8_WAIT_L(0); PG8_BAR; PG8_MMA(0, 0, At, B0); PG8_MMA(0, 1, At, B1); PG8_BAR; PG8_SCHED;
            PG8_LDA(At, 0, 1); PG8_STAGE(PG8_SB(0, 0), b2, voffB); PG8_STAGE(PG8_SB(0, 1), b2 + hstep, voffB); PG8_STAGE(PG8_SA(0, 0), a2, voffA);
            PG8_WAIT_V(8); PG8_WAIT_L(0); PG8_BAR; PG8_MMA(1, 0, At, B0); PG8_MMA(1, 1, At, B1); PG8_BAR; PG8_SCHED;
            PG8_LDB(B0, 1, 0); PG8_LDB(B1, 1, 1); PG8_SCHED; PG8_LDA(At, 1, 0); PG8_STAGE(PG8_SA(0, 1), a2 + hstep, voffA);
            PG8_WAIT_V(8); PG8_WAIT_L(0); PG8_BAR; PG8_MMA(0, 0, At, B0); PG8_MMA(0, 1, At, B1); PG8_BAR; PG8_SCHED;
            PG8_LDA(At, 1, 1); PG8_STAGE(PG8_SB(1, 0), b3, voffB); PG8_STAGE(PG8_SB(1, 1), b3 + hstep, voffB); PG8_STAGE(PG8_SA(1, 0), a3, voffA);
            PG8_WAIT_V(8); PG8_WAIT_L(0); PG8_BAR; PG8_MMA(1, 0, At, B0); PG8_MMA(1, 1, At, B1); PG8_BAR; PG8_SCHED;
            } else {
            PG8_LDB(B0, 0, 0); PG8_SCHED; PG8_LDA(At, 0, 0); PG8_STAGE(PG8_SA(1, 1), a1 + hstep, voffA);
            PG8_WAIT_L(8); PG8_BAR; PG8_WAIT_L(0); PG8_MMA(0, 0, At, B0); PG8_BAR; PG8_SCHED;
            PG8_LDB(B1, 0, 1); PG8_STAGE(PG8_SB(0, 0), b2, voffB);
            PG8_BAR; PG8_WAIT_L(0); PG8_MMA(0, 1, At, B1); PG8_BAR;
            PG8_LDA(At, 0, 1); PG8_STAGE(PG8_SA(0, 0), a2, voffA);
            PG8_BAR; PG8_WAIT_L(0); PG8_MMA(1, 0, At, B0); PG8_BAR; PG8_SCHED;
            PG8_STAGE(PG8_SB(0, 1), b2 + hstep, voffB);
            PG8_WAIT_V(6); PG8_BAR; PG8_MMA(1, 1, At, B1); PG8_BAR;
            PG8_LDB(B0, 1, 0); PG8_SCHED; PG8_LDA(At, 1, 0); PG8_STAGE(PG8_SA(0, 1), a2 + hstep, voffA);
            PG8_WAIT_L(8); PG8_BAR; PG8_WAIT_L(0); PG8_MMA(0, 0, At, B0); PG8_BAR; PG8_SCHED;
            PG8_LDB(B1, 1, 1); PG8_STAGE(PG8_SB(1, 0), b3, voffB);
            PG8_BAR; PG8_WAIT_L(0); PG8_MMA(0, 1, At, B1); PG8_BAR;
            PG8_LDA(At, 1, 1); PG8_STAGE(PG8_SA(1, 0), a3, voffA);
            PG8_BAR; PG8_WAIT_L(0); PG8_MMA(1, 0, At, B0); PG8_BAR; PG8_SCHED;
            PG8_STAGE(PG8_SB(1, 1), b3 + hstep, voffB);
            PG8_WAIT_V(6); PG8_BAR; PG8_MMA(1, 1, At, B1); PG8_BAR;
            }
        }
        if constexpr (ALIGN_EPI) { if (wr == 0) PG8_BAR; }
        if constexpr (!Epi::AFTER_DRAIN) { E(acc, cur, wr, wc, fr, fq); S.done(cur); }
        if (!has_next) break;
#pragma unroll
        for (int a = 0; a < 2; ++a)
#pragma unroll
            for (int b = 0; b < 2; ++b)
#pragma unroll
                for (int m = 0; m < 4; ++m)
#pragma unroll
                    for (int n = 0; n < 2; ++n) acc[a][b][m][n] = (f32x4){0.f, 0.f, 0.f, 0.f};
        cur = nxt; cA = nA; cB = nB; ++ui;
        if constexpr (ALIGN_EPI) { if (wr == 1) PG8_BAR; }
    }
    PG8_WAIT_V(0);
    if constexpr (!ALIGN_EPI) { if (wr == 0) PG8_BAR; }
    PG8_BAR;
    if constexpr (Epi::AFTER_DRAIN) { E.fused(acc, cur, wr, wc, fr, fq, lds, wid, lane); S.done(cur); }
#undef PG8_SA
#undef PG8_SB
#undef PG8_STAGE
#undef PG8_LDA
#undef PG8_LDB
#undef PG8_MMA
#undef PG8_WAIT_V
#undef PG8_WAIT_L
#undef PG8_BAR
#undef PG8_SCHED
}
}

struct EpiStoreBf16 {
    static constexpr bool PERM = true, AFTER_DRAIN = false;
    bf16_t* O; int ldc;
    __device__ __forceinline__ void operator()(const pg8::f32x4 (&acc)[2][2][4][2], const pg8::Unit& u, int wr, int wc, int fr, int fq) const {
        const int row0 = u.pm * 256 + wr * 64 + fr, col0 = u.pn * 256 + wc * 32 + 8 * fq;
#pragma unroll
        for (int ai = 0; ai < 2; ++ai)
#pragma unroll
            for (int m = 0; m < 4; ++m) { bf16_t* rowp = O + (size_t)(row0 + ai * 128 + m * 16) * ldc + col0;
#pragma unroll
                for (int bj = 0; bj < 2; ++bj) { const pg8::f32x4 v0 = acc[ai][bj][m][0], v1 = acc[ai][bj][m][1];
                    u32x4 w; w.x = pk2(v0[0], v0[1]); w.y = pk2(v0[2], v0[3]); w.z = pk2(v1[0], v1[1]); w.w = pk2(v1[2], v1[3]);
                    *(u32x4*)(rowp + bj * 128) = w; } }
    }
};
struct EpiResid {
    static constexpr bool PERM = true, AFTER_DRAIN = false;
    Params p; int row_base; const float* ln_g; const float* ln_b;
    __device__ __forceinline__ void operator()(const pg8::f32x4 (&acc)[2][2][4][2], const pg8::Unit& u, int wr, int wc, int fr, int fq) const {
        const int row0 = row_base + u.pm * 256 + wr * 64 + fr, col0 = u.pn * 256 + wc * 32 + 8 * fq; const float al = alpha_of_depth();
        const float* stats = (const float*)(p.ws + OFF_STATS);
        f32x4 g0[2], g1[2], b0[2], b1[2];
        if (ln_g) {
#pragma unroll
            for (int bj = 0; bj < 2; ++bj) { g0[bj] = *(const f32x4*)(ln_g + col0 + bj * 128); g1[bj] = *(const f32x4*)(ln_g + col0 + bj * 128 + 4); b0[bj] = *(const f32x4*)(ln_b + col0 + bj * 128); b1[bj] = *(const f32x4*)(ln_b + col0 + bj * 128 + 4); } }
#pragma unroll
        for (int ai = 0; ai < 2; ++ai)
#pragma unroll
            for (int m = 0; m < 4; ++m) { const int R = row0 + ai * 128 + m * 16, seq = R / LP, t = R - seq * LP;
                if (t < L) { float* hp = hrow(p, seq, t) + col0; float mean = 0.f, rstd = 1.f;
                    if (ln_g) { mean = stats[2 * (seq * L + t)]; rstd = stats[2 * (seq * L + t) + 1]; }
#pragma unroll
                    for (int bj = 0; bj < 2; ++bj) { f32x4 h0 = *(f32x4*)(hp + bj * 128), h1 = *(f32x4*)(hp + bj * 128 + 4);
                        if (ln_g) { h0 = (h0 - mean) * rstd * g0[bj] + b0[bj]; h1 = (h1 - mean) * rstd * g1[bj] + b1[bj]; }
                        h0 = h0 * al + acc[ai][bj][m][0]; h1 = h1 * al + acc[ai][bj][m][1];
                        *(f32x4*)(hp + bj * 128) = h0; *(f32x4*)(hp + bj * 128 + 4) = h1; } } }
    }
};

__device__ __forceinline__ void stage_rope(const Params& p) {
    float* cs = (float*)(p.ws + OFF_ROPE);
    for (int idx = blockIdx.x * NT + otid(); idx < L * 8; idx += gridDim.x * NT) {
        const int t = idx >> 3, i = idx & 7;
        const double invs[8] = {1.0, 0.19392274474868576, 0.03760603093086393, 0.007292664737217109, 0.001414213562373095, 0.0002742481756762073, 5.318295896944988e-05, 1.031338537721246e-05};
        double inv = invs[0];
#pragma unroll
        for (int k = 1; k < 8; ++k) inv = i == k ? invs[k] : inv;
        const double x = (double)t * inv * 0.15915494309189533577; float sn, cn; sincos2pi((float)(x - floor(x)), &sn, &cn);
        cs[2 * idx] = cn; cs[2 * idx + 1] = sn;
    }
}
__device__ __forceinline__ void convert_tile(const float* W, int K, int N, bf16_t* WT, int unit, int nkb, LAS unsigned char* lds) {
    LAS float* tile = (LAS float*)lds;
    const int kb = unit % nkb, nb = unit / nkb, k0 = kb * 64, n0 = nb * 64, tid = otid();
    { const int kk = tid >> 4, n4 = (tid & 15) * 4;
#pragma unroll
      for (int h = 0; h < 2; ++h) { const int k = kk + 32 * h; f32x4 v = {0.f, 0.f, 0.f, 0.f};
          if (n0 + n4 < N) v = *(const f32x4*)(W + (size_t)(k0 + k) * N + n0 + n4);
          tile[k * 65 + n4] = v[0]; tile[k * 65 + n4 + 1] = v[1]; tile[k * 65 + n4 + 2] = v[2]; tile[k * 65 + n4 + 3] = v[3]; } }
    __syncthreads();
    { const int n = tid >> 3, pc = tid & 7; const LAS float* s = tile + (8 * pc) * 65 + n;
      u32x4 o; o.x = pk2(s[0], s[65]); o.y = pk2(s[2 * 65], s[3 * 65]); o.z = pk2(s[4 * 65], s[5 * 65]); o.w = pk2(s[6 * 65], s[7 * 65]);
      *(u32x4*)(WT + (size_t)(n0 + n) * K + k0 + 8 * pc) = o; }
    __syncthreads();
}
__device__ __forceinline__ void stage_convert_weights(const Params& p, int l, LAS unsigned char* lds) {
    constexpr int U_IN = (DM / 64) * (PP / 64), U_OUT = (DM / 64) * (DM / 64), U_UP = (DM / 64) * (2 * DFF / 64), U_DOWN = (DFF / 64) * (DM / 64);
    for (int u = blockIdx.x; u < U_IN + U_OUT + U_UP + U_DOWN; u += gridDim.x) {
        int r = u;
        if (r < U_IN) { convert_tile(p.in[I_WIN] + (size_t)l * DM * DIN, DM, DIN, (bf16_t*)(p.ws + OFF_WIN), r, DM / 64, lds); continue; } r -= U_IN;
        if (r < U_OUT) { convert_tile(p.in[I_WOUT] + (size_t)l * DM * DM, DM, DM, (bf16_t*)(p.ws + OFF_WOUT), r, DM / 64, lds); continue; } r -= U_OUT;
        if (r < U_UP) { convert_tile(p.in[I_WUP] + (size_t)l * DM * 2 * DFF, DM, 2 * DFF, (bf16_t*)(p.ws + OFF_WUP), r, DM / 64, lds); continue; } r -= U_UP;
        convert_tile(p.in[I_WDOWN] + (size_t)l * DFF * DM, DFF, DM, (bf16_t*)(p.ws + OFF_WDOWN), r, DFF / 64, lds);
    }
}
__device__ __forceinline__ void ln_row(f32x4 (&v)[8], const f32x4 (&gg)[8], const f32x4 (&bb)[8], float* of32, bf16_t* obf, int lane, float& mean_o, float& rstd_o) {
    float s = 0.f;
#pragma unroll
    for (int j = 0; j < 8; ++j) s += (v[j][0] + v[j][1]) + (v[j][2] + v[j][3]);
    const float mean = wave_sum(s) * (1.f / DM); float s2 = 0.f;
#pragma unroll
    for (int j = 0; j < 8; ++j) { v[j] = v[j] - mean; s2 += (v[j][0] * v[j][0] + v[j][1] * v[j][1]) + (v[j][2] * v[j][2] + v[j][3] * v[j][3]); }
    const float rstd = 1.f / sqrtf(wave_sum(s2) * (1.f / DM) + LN_EPS);
    mean_o = mean; rstd_o = rstd;
#pragma unroll
    for (int j = 0; j < 8; ++j) { const int c4 = lane + 64 * j;
        const f32x4 o = v[j] * rstd * gg[j] + bb[j]; if (of32) ((f32x4*)of32)[c4] = o;
        u32x2 w; w.x = pk2(o[0], o[1]); w.y = pk2(o[2], o[3]); ((u32x2*)obf)[c4] = w; }
}
__device__ __forceinline__ void stage_embed(const Params& p) {
    const int lane = otid() & 63, gw = blockIdx.x * 8 + (otid() >> 6), NGW = gridDim.x * 8;
    bf16_t* hbf = (bf16_t*)(p.ws + OFF_HBF);
    f32x4 gg[8], bb[8];
#pragma unroll
    for (int j = 0; j < 8; ++j) { gg[j] = ((const f32x4*)p.in[I_EMBG])[lane + 64 * j]; bb[j] = ((const f32x4*)p.in[I_EMBB])[lane + 64 * j]; }
    for (int r = gw; r < NSEQ * LP; r += NGW) {
        const int seq = r / LP, t = r - seq * LP; bf16_t* ob = hbf + (size_t)r * DM;
        if (t >= L) { for (int j = 0; j < 4; ++j) ((u32x4*)ob)[lane + 64 * j] = (u32x4){0u, 0u, 0u, 0u}; continue; }
        const float* src = t < NMETA ? p.in[I_META] + (size_t)t * DM : (seq < NSEQ - 1 ? p.in[I_XP] + ((size_t)seq * SEQ + (t - NMETA)) * DM : p.in[I_XS] + (size_t)(t - NMETA) * DM);
        f32x4 v[8];
#pragma unroll
        for (int j = 0; j < 8; ++j) v[j] = ((const f32x4*)src)[lane + 64 * j];
        float mu, rs; ln_row(v, gg, bb, hrow(p, seq, t), ob, lane, mu, rs);
    }
}
__device__ __forceinline__ void stage_ln(const Params& p, int l, int which) {
    const int lane = otid() & 63, gw = blockIdx.x * 8 + (otid() >> 6), NGW = gridDim.x * 8;
    bf16_t* hbf = (bf16_t*)(p.ws + OFF_HBF); float* stats = (float*)(p.ws + OFF_STATS);
    const float* g = p.in[which ? I_LN2G : I_LN1G] + (size_t)l * DM; const float* b = p.in[which ? I_LN2B : I_LN1B] + (size_t)l * DM;
    const bool last = which == 1 && l == DEPTH - 1;
    f32x4 gg[8], bb[8];
#pragma unroll
    for (int j = 0; j < 8; ++j) { gg[j] = ((const f32x4*)g)[lane + 64 * j]; bb[j] = ((const f32x4*)b)[lane + 64 * j]; }
    for (int r = gw; r < NSEQ * L; r += 2 * NGW) {
        const int r1 = r + NGW; const bool two = r1 < NSEQ * L;
        const int seq = r / L, t = r - seq * L, seq1 = two ? r1 / L : seq, t1 = two ? r1 - seq1 * L : t; float* hp = hrow(p, seq, t); float* hp1 = hrow(p, seq1, t1);
        f32x4 v[8], v1[8];
#pragma unroll
        for (int j = 0; j < 8; ++j) { v[j] = ((const f32x4*)hp)[lane + 64 * j]; v1[j] = ((const f32x4*)hp1)[lane + 64 * j]; }
        float mu, rs; ln_row(v, gg, bb, last ? hp : nullptr, hbf + ((size_t)seq * LP + t) * DM, lane, mu, rs);
        if (lane == 0) { stats[2 * r] = mu; stats[2 * r + 1] = rs; }
        if (two) { ln_row(v1, gg, bb, last ? hp1 : nullptr, hbf + ((size_t)seq1 * LP + t1) * DM, lane, mu, rs);
            if (lane == 0) { stats[2 * r1] = mu; stats[2 * r1 + 1] = rs; } }
    }
}
template <class Epi> __device__ __forceinline__ void stage_gemm(LAS unsigned char* lds, const bf16_t* A, const bf16_t* Bt, int M, int N, int K, const Epi& E) {
    pg8::Gemm g; g.A = A; g.Bt = Bt; g.M = M; g.N = N; g.K = K;
    pg8::StaticOrder S; S.init(M, N, gridDim.x, blockIdx.x);
    pg8::gemm_phase<Epi, pg8::StaticOrder, true, true>(lds, g, S, E);
    __syncthreads();
}

template <bool RESID> __device__ __forceinline__ void tail_gemm(const Params& p, const bf16_t* A, const bf16_t* Bt, int N, int K, bf16_t* O, int ldc, int seq, LAS unsigned char* lds, const float* ln_g = nullptr, const float* ln_b = nullptr) {
    const int tid = otid(), wid = tid >> 6, lane = tid & 63, r16 = lane & 15, q4 = lane >> 4; LAS f32x4* part = (LAS f32x4*)lds;
    for (int nt = blockIdx.x; nt < N / 16; nt += gridDim.x) {
        f32x4 acc = {0.f, 0.f, 0.f, 0.f};
        const bf16_t* ap = A + (size_t)r16 * K + 8 * q4 + 32 * wid; const bf16_t* bp = Bt + (size_t)(16 * nt + r16) * K + 8 * q4 + 32 * wid;
        const int nst = K / 256;
        for (int s0 = 0; s0 < nst; s0 += 4) { pg8::bf16x8 av[4], bv[4];
#pragma unroll
            for (int q = 0; q < 4; ++q) if (s0 + q < nst) { av[q] = *(const pg8::bf16x8*)(ap + 256 * (s0 + q)); bv[q] = *(const pg8::bf16x8*)(bp + 256 * (s0 + q)); }
#pragma unroll
            for (int q = 0; q < 4; ++q) if (s0 + q < nst) acc = __builtin_amdgcn_mfma_f32_16x16x32_bf16(av[q], bv[q], acc, 0, 0, 0); }
        __syncthreads();
        part[tid] = acc;
        __syncthreads();
        if (wid == 0) {
#pragma unroll
            for (int w = 1; w < 8; ++w) acc = acc + part[w * 64 + lane];
            const int col = 16 * nt + r16;
#pragma unroll
            for (int j = 0; j < 4; ++j) { const int t = SEQ + 4 * q4 + j;
                if constexpr (RESID) { float* hp = hrow(p, seq, t) + col; float hv = *hp;
                    if (ln_g) { const float* st = (const float*)(p.ws + OFF_STATS) + 2 * (seq * L + t); hv = (hv - st[0]) * st[1] * ln_g[col] + ln_b[col]; }
                    *hp = hv * alpha_of_depth() + acc[j]; }
                else O[(size_t)(4 * q4 + j) * ldc + col] = (bf16_t)f2bf(acc[j]); } }
    }
    __syncthreads();
}
__device__ __forceinline__ void stage_ffn_conv(const Params& p, int l) {
    const bf16_t* u = (const bf16_t*)(p.ws + OFF_U); bf16_t* act = (bf16_t*)(p.ws + OFF_ACT);
    const float* cw = p.in[I_FCW] + (size_t)l * 3 * 2 * DFF; const float* cb = p.in[I_FCB] + (size_t)l * 2 * DFF;
    constexpr int C8 = DFF / 8, R4 = LP / 4;
    for (long idx = (long)blockIdx.x * NT + otid(); idx < (long)R4 * C8; idx += (long)gridDim.x * NT) {
        const int t0 = (int)(idx / C8) * 4, c = (int)(idx % C8) * 8;
        if (t0 >= L) {
#pragma unroll
            for (int q = 0; q < 4; ++q) *(u32x4*)(act + (size_t)(t0 + q) * DFF + c) = (u32x4){0u, 0u, 0u, 0u};
            continue; }
        float wg[3][8], wv[3][8], bg[8], bv[8];
#pragma unroll
        for (int j = 0; j < 8; ++j) { bg[j] = cb[c + j]; bv[j] = cb[DFF + c + j];
#pragma unroll
            for (int d = 0; d < 3; ++d) { wg[d][j] = cw[(size_t)d * 2 * DFF + c + j]; wv[d][j] = cw[(size_t)d * 2 * DFF + DFF + c + j]; } }
        u32x4 ra[6], rb[6];
#pragma unroll
        for (int q = 0; q < 6; ++q) { const int tt = t0 + q - 1; ra[q] = (u32x4){0u, 0u, 0u, 0u}; rb[q] = ra[q];
            if (tt >= 0 && tt < L) { ra[q] = *(const u32x4*)(u + (size_t)tt * 2 * DFF + c); rb[q] = *(const u32x4*)(u + (size_t)tt * 2 * DFF + DFF + c); } }
#pragma unroll
        for (int q = 0; q < 4; ++q) { const int t = t0 + q; u32x4 o = {0u, 0u, 0u, 0u};
            if (t < L) { float g[8], v[8];
#pragma unroll
                for (int j = 0; j < 8; ++j) { g[j] = bg[j]; v[j] = bv[j]; }
#pragma unroll
                for (int d = 0; d < 3; ++d)
#pragma unroll
                    for (int j = 0; j < 4; ++j) { const unsigned a = ra[q + d][j], b = rb[q + d][j];
                        g[2 * j] += wg[d][2 * j] * __uint_as_float(a << 16); g[2 * j + 1] += wg[d][2 * j + 1] * __uint_as_float(a & 0xffff0000u);
                        v[2 * j] += wv[d][2 * j] * __uint_as_float(b << 16); v[2 * j + 1] += wv[d][2 * j + 1] * __uint_as_float(b & 0xffff0000u); }
#pragma unroll
                for (int j = 0; j < 4; ++j) o[j] = pk2(siluf_(g[2 * j]) * v[2 * j], siluf_(g[2 * j + 1]) * v[2 * j + 1]); }
            *(u32x4*)(act + (size_t)t * DFF + c) = o; }
    }
}
#define MFMA32(a, b, c) __builtin_amdgcn_mfma_f32_32x32x16_bf16((a), (b), (c), 0, 0, 0)
#define MFMA16(a, b, c) __builtin_amdgcn_mfma_f32_16x16x32_bf16((a), (b), (c), 0, 0, 0)
__device__ __forceinline__ int crow32(int i, int h) { return (i & 3) + 8 * (i >> 2) + 4 * h; }
__device__ __forceinline__ bf16x8 pack8(const f32x16& x, int s) {
    u32x4 p; p.x = pk2(x[8 * s], x[8 * s + 1]); p.y = pk2(x[8 * s + 2], x[8 * s + 3]); p.z = pk2(x[8 * s + 4], x[8 * s + 5]); p.w = pk2(x[8 * s + 6], x[8 * s + 7]);
    return __builtin_bit_cast(bf16x8, p);
}
__device__ __forceinline__ void attn_prep_unit(const Params& p, int unit, LAS unsigned char* lds) {
    const bf16_t* proj = (const bf16_t*)(p.ws + OFF_PROJ); bf16_t* Qr = (bf16_t*)(p.ws + OFF_QR); bf16_t* Kr = (bf16_t*)(p.ws + OFF_KR); bf16_t* Vt = (bf16_t*)(p.ws + OFF_VT);
    const float* cs = (const float*)(p.ws + OFF_ROPE);
    int tid_ = otid(); const int t0 = unit * 64, tid = tid_; LAS bf16_t* Vs = (LAS bf16_t*)lds;
    constexpr float QS = 0.125f * 1.4426950408889634f;
    for (int it = 0; it < 16; ++it) { const int idx = tid + NT * it, tl = idx >> 7, pc = idx & 127, t = t0 + tl, col8 = pc * 8, isk = col8 >= 512, cc = col8 & 511, map = cc >> 6, d0 = cc & 63;
        u32x4 o = {0u, 0u, 0u, 0u};
        if (t < L) { const u32x4 xv = *(const u32x4*)(proj + (size_t)t * PP + col8);
            if (d0 < 16) { const u32x4 yv = *(const u32x4*)(proj + (size_t)t * PP + (col8 ^ 8)); float x[8], y[8], r[8];
#pragma unroll
                for (int j = 0; j < 4; ++j) { x[2 * j] = __uint_as_float(xv[j] << 16); x[2 * j + 1] = __uint_as_float(xv[j] & 0xffff0000u); y[2 * j] = __uint_as_float(yv[j] << 16); y[2 * j + 1] = __uint_as_float(yv[j] & 0xffff0000u); }
#pragma unroll
                for (int j = 0; j < 8; ++j) { const float c = cs[(t * 8 + j) * 2], s = cs[(t * 8 + j) * 2 + 1]; r[j] = d0 == 0 ? x[j] * c - y[j] * s : x[j] * c + y[j] * s; if (!isk) r[j] *= QS; }
#pragma unroll
                for (int j = 0; j < 4; ++j) o[j] = pk2(r[2 * j], r[2 * j + 1]);
            } else if (isk) o = xv;
            else {
#pragma unroll
                for (int j = 0; j < 4; ++j) o[j] = pk2(__uint_as_float(xv[j] << 16) * QS, __uint_as_float(xv[j] & 0xffff0000u) * QS); } }
        *(u32x4*)((isk ? Kr : Qr) + ((size_t)map * LP + t) * 64 + d0) = o; }
    for (int it = 0; it < 8; ++it) { const int idx = tid + NT * it, tl = idx >> 6, pc = idx & 63, t = t0 + tl;
        u32x4 v = {0u, 0u, 0u, 0u}; if (t < L) v = *(const u32x4*)(proj + (size_t)t * PP + CA_V + pc * 8);
        *(LAS u32x4*)(Vs + tl * 520 + pc * 8) = v; }
    __syncthreads();
    for (int it = 0; it < 8; ++it) { const int idx = tid + NT * it, c = idx & 511, pp = idx >> 9, kb = pp >> 2, s = (pp >> 1) & 1, hh = pp & 1;
        unsigned short e[8];
#pragma unroll
        for (int a = 0; a < 2; ++a)
#pragma unroll
            for (int b = 0; b < 4; ++b) e[4 * a + b] = Vs[(32 * kb + 16 * s + 8 * a + 4 * hh + b) * 520 + c];
        u32x4 o; o.x = e[0] | ((unsigned)e[1] << 16); o.y = e[2] | ((unsigned)e[3] << 16); o.z = e[4] | ((unsigned)e[5] << 16); o.w = e[6] | ((unsigned)e[7] << 16);
        *(u32x4*)(Vt + (size_t)c * LP + t0 + 8 * pp) = o; }
    __syncthreads();
}
__device__ __forceinline__ void attn_unit(const Params& p, int unit, LAS unsigned char* lds) {
    const bf16_t* Qr = (const bf16_t*)(p.ws + OFF_QR); const bf16_t* Kr = (const bf16_t*)(p.ws + OFF_KR); const bf16_t* Vt = (const bf16_t*)(p.ws + OFF_VT);
    int tid_ = otid(); const int tid = tid_, wid = tid >> 6, lane = tid & 63, r = lane & 31, h = lane >> 5;
    const int hm = unit & 7, hd = hm >> 1, m = hm & 1, qb = unit >> 3, q0 = qb * 256 + wid * 32;
    constexpr int KB = 9216, VB = 18432, OFFV = 3 * KB, OFFS = 3 * KB + 2 * VB, NKT = (L + 63) / 64;
    LAS float* scr = (LAS float*)(lds + OFFS) + wid * 32;
    float* ao = (float*)(p.ws + OFF_AO0) + (size_t)m * LP * 512;
    const bf16_t* Qm = Qr + (size_t)(2 * hd + m) * LP * 64; const bf16_t* Km = Kr + (size_t)(2 * hd + m) * LP * 64; const bf16_t* Vh = Vt + (size_t)hd * 128 * LP;
    bf16x8 qf[4];
#pragma unroll
    for (int ks = 0; ks < 4; ++ks) qf[ks] = *(const bf16x8*)(Qm + (unsigned)((q0 + r) * 64 + 16 * ks + 8 * h));
    f32x16 z[4];
#pragma unroll
    for (int d = 0; d < 4; ++d)
#pragma unroll
        for (int i = 0; i < 16; ++i) z[d][i] = 0.f;
    float m_run = -INFINITY, l_run = 0.f;
    const int krow_ = tid >> 3, kpc = tid & 7;
    const unsigned koff = (unsigned)(krow_ * 64 + kpc * 8), voff = (unsigned)(krow_ * LP + kpc * 8);
    const unsigned kl = (unsigned)(krow_ * 144 + kpc * 16), vl = (unsigned)(OFFV + krow_ * 144 + kpc * 16);
    { const u32x4 k0 = *(const u32x4*)(Km + koff), v0 = *(const u32x4*)(Vh + voff), v1 = *(const u32x4*)(Vh + voff + 64u * LP);
      u32x4 k1 = {0u, 0u, 0u, 0u}; if (NKT > 1) k1 = *(const u32x4*)(Km + koff + 64u * 64u);
      *(LAS u32x4*)(lds + kl) = k0; *(LAS u32x4*)(lds + KB + kl) = k1; *(LAS u32x4*)(lds + vl) = v0; *(LAS u32x4*)(lds + vl + 64 * 144) = v1; }
    __syncthreads();
    f32x16 xc[2];
#pragma unroll
    for (int kb = 0; kb < 2; ++kb) {
#pragma unroll
        for (int i = 0; i < 16; ++i) xc[kb][i] = 0.f;
#pragma unroll
        for (int ks = 0; ks < 4; ++ks) { const bf16x8 a = *(const LAS bf16x8*)(lds + (32 * kb + r) * 144 + (16 * ks + 8 * h) * 2); xc[kb] = MFMA32(a, qf[ks], xc[kb]); } }
    int kslot = 0;
    for (int kt = 0; kt < NKT; ++kt) {
        const int ks1 = kslot == 2 ? 0 : kslot + 1, ks2 = ks1 == 2 ? 0 : ks1 + 1;
        LAS unsigned char* Vb = lds + OFFV + (kt & 1) * VB; LAS unsigned char* Kn = lds + ks1 * KB;
        u32x4 kreg = {0u, 0u, 0u, 0u}, vreg0 = kreg, vreg1 = kreg;
        if (kt + 2 < NKT) kreg = *(const u32x4*)(Km + koff + (unsigned)(kt + 2) * 4096u);
        if (kt + 1 < NKT) { const unsigned k1 = (unsigned)(kt + 1) * 64u; vreg0 = *(const u32x4*)(Vh + voff + k1); vreg1 = *(const u32x4*)(Vh + voff + 64u * LP + k1); }
        bf16x8 kf[8];
#pragma unroll
        for (int kb = 0; kb < 2; ++kb)
#pragma unroll
            for (int ks = 0; ks < 4; ++ks) kf[4 * kb + ks] = *(const LAS bf16x8*)(Kn + (32 * kb + r) * 144 + (16 * ks + 8 * h) * 2);
        __builtin_amdgcn_sched_barrier(0);
        if ((L & 63) != 0 && kt == NKT - 1) {
#pragma unroll
            for (int kb = 0; kb < 2; ++kb)
#pragma unroll
                for (int i = 0; i < 16; ++i) if (kt * 64 + 32 * kb + crow32(i, h) >= L) xc[kb][i] = -INFINITY; }
        float mx = xc[0][0];
#pragma unroll
        for (int kb = 0; kb < 2; ++kb)
#pragma unroll
            for (int i = 0; i < 16; ++i) mx = fmaxf(mx, xc[kb][i]);
        if (__any(mx > m_run + 8.f)) {
            const float mo = fmaxf(mx, __shfl_xor(mx, 32)), m_new = mo > m_run + 8.f ? mo : m_run, alpha = fexp2(m_run - m_new); m_run = m_new; l_run *= alpha;
            if (h == 0) scr[r] = alpha;
            WAVE_SYNC();
#pragma unroll
            for (int g = 0; g < 4; ++g) { const f32x4 af = *(const LAS f32x4*)(scr + 8 * g + 4 * h);
#pragma unroll
                for (int d = 0; d < 4; ++d)
#pragma unroll
                    for (int j = 0; j < 4; ++j) z[d][4 * g + j] *= af[j]; }
            WAVE_SYNC();
        }
        __builtin_amdgcn_sched_barrier(0);
        f32x16 xn[2];
#pragma unroll
        for (int kb = 0; kb < 2; ++kb) {
#pragma unroll
            for (int i = 0; i < 16; ++i) xn[kb][i] = 0.f;
#pragma unroll
            for (int ks = 0; ks < 4; ++ks) xn[kb] = MFMA32(kf[4 * kb + ks], qf[ks], xn[kb]); }
        bf16x8 vfa[8], vfb[8];
#pragma unroll
        for (int s2 = 0; s2 < 2; ++s2)
#pragma unroll
            for (int d = 0; d < 4; ++d) vfa[4 * s2 + d] = *(const LAS bf16x8*)(Vb + (32 * d + r) * 144 + (16 * s2 + 8 * h) * 2);
        __builtin_amdgcn_sched_barrier(0);
        float ps = 0.f;
#pragma unroll
        for (int kb = 0; kb < 2; ++kb)
#pragma unroll
            for (int i = 0; i < 16; ++i) { xc[kb][i] = fexp2(xc[kb][i] - m_run); ps += xc[kb][i]; }
        l_run += ps;
        bf16x8 pf[4];
#pragma unroll
        for (int kb = 0; kb < 2; ++kb)
#pragma unroll
            for (int s2 = 0; s2 < 2; ++s2) pf[2 * kb + s2] = pack8(xc[kb], s2);
        __builtin_amdgcn_sched_barrier(0);
#pragma unroll
        for (int s2 = 0; s2 < 2; ++s2)
#pragma unroll
            for (int d = 0; d < 4; ++d) vfb[4 * s2 + d] = *(const LAS bf16x8*)(Vb + (32 * d + r) * 144 + (32 + 16 * s2 + 8 * h) * 2);
#pragma unroll
        for (int s2 = 0; s2 < 2; ++s2)
#pragma unroll
            for (int d = 0; d < 4; ++d) z[d] = MFMA32(pf[s2], vfa[4 * s2 + d], z[d]);
        __builtin_amdgcn_sched_barrier(0);
#pragma unroll
        for (int s2 = 0; s2 < 2; ++s2)
#pragma unroll
            for (int d = 0; d < 4; ++d) z[d] = MFMA32(pf[2 + s2], vfb[4 * s2 + d], z[d]);
        if (kt + 2 < NKT) *(LAS u32x4*)(lds + ks2 * KB + kl) = kreg;
        if (kt + 1 < NKT) { const unsigned vn = (unsigned)(((kt + 1) & 1) * VB); *(LAS u32x4*)(lds + vn + vl) = vreg0; *(LAS u32x4*)(lds + vn + vl + 64 * 144) = vreg1; }
        __syncthreads();
        xc[0] = xn[0]; xc[1] = xn[1]; kslot = ks1;
    }
    l_run += __shfl_xor(l_run, 32);
    if (h == 0) scr[r] = 1.f / l_run;
    WAVE_SYNC();
    { unsigned ro = (unsigned)((q0 + 4 * h) * 512 + hd * 128 + r); OPAQUE(ro);
#pragma unroll
      for (int g = 0; g < 4; ++g) { const f32x4 af = *(const LAS f32x4*)(scr + 8 * g + 4 * h);
#pragma unroll
          for (int j = 0; j < 4; ++j)
#pragma unroll
              for (int d = 0; d < 4; ++d) ao[ro + (unsigned)(crow32(4 * g + j, 0) * 512 + 32 * d)] = z[d][4 * g + j] * af[j]; } }
    WAVE_SYNC();
}
__device__ __forceinline__ void stage_hyena_filter_raw(const Params& p, int l, LAS unsigned char* lds) {
    const float* w1 = p.in[I_HW1] + (size_t)l * 33 * 64; const float* b1 = p.in[I_HB1] + l * 64; const float* f1 = p.in[I_HF1] + l * 64;
    const float* w2 = p.in[I_HW2] + (size_t)l * 64 * 64; const float* b2 = p.in[I_HB2] + l * 64; const float* f2 = p.in[I_HF2] + l * 64;
    const float* w3 = p.in[I_HW3] + (size_t)l * 64 * 1024; const float* dec = p.in[I_HDEC] + (size_t)l * 1024;
    float* raw = (float*)(p.ws + OFF_RAW); float* part = (float*)(p.ws + OFF_HPART);
    LAS float* zs = (LAS float*)lds; LAS float* h1 = zs + 8 * 33; LAS float* h2 = h1 + 8 * 64;
    const int tid = otid(); float ps0 = 0.f, ps1 = 0.f;
    const float d0 = fabsf(dec[tid]), d1 = fabsf(dec[512 + tid]);
    for (int u = blockIdx.x; u < (L + 7) / 8; u += gridDim.x) {
        const int t0 = u * 8;
        if (tid < 8 * 33) { const int tl = tid / 33, e = tid - tl * 33, t = t0 + tl; float v;
            if (e == 0) v = (float)((double)t / (double)(L - 1));
            else { const int b = (e - 1) & 15; const double band = 1e-4 + (double)b * ((15.0 - 1e-4) / 15.0), x = (double)t * band / (double)L; float sn, cn; sincos2pi((float)(x - floor(x)), &sn, &cn);
                v = e <= 16 ? cn : -sn; }
            zs[tid] = v; }
        __syncthreads();
        { const int tl = tid >> 6, j = tid & 63; float s = b1[j];
#pragma unroll 3
          for (int e = 0; e < 33; ++e) s += zs[tl * 33 + e] * w1[e * 64 + j];
          h1[tid] = sinf(f1[j] * s); }
        __syncthreads();
        { const int tl = tid >> 6, j = tid & 63; float s = b2[j];
#pragma unroll 4
          for (int e = 0; e < 64; ++e) s += h1[tl * 64 + e] * w2[e * 64 + j];
          h2[tid] = sinf(f2[j] * s); }
        __syncthreads();
        float a0[8], a1[8];
#pragma unroll
        for (int i = 0; i < 8; ++i) { a0[i] = 0.f; a1[i] = 0.f; }
#pragma unroll 8
        for (int k = 0; k < 64; ++k) { const float wa = w3[k * 1024 + tid], wb = w3[k * 1024 + 512 + tid];
#pragma unroll
            for (int i = 0; i < 8; ++i) { const float hv = h2[i * 64 + k]; a0[i] += hv * wa; a1[i] += hv * wb; } }
#pragma unroll
        for (int i = 0; i < 8; ++i) { const int t = t0 + i; if (t < L) { const float tl = zs[i * 33];
            const float v0 = a0[i] * (expf(-tl * d0) + 0.05f), v1 = a1[i] * (expf(-tl * d1) + 0.05f);
            raw[(size_t)t * 1024 + tid] = v0; raw[(size_t)t * 1024 + 512 + tid] = v1; ps0 += fabsf(v0); ps1 += fabsf(v1); } }
        __syncthreads();
    }
    part[(size_t)blockIdx.x * 1024 + tid] = ps0; part[(size_t)blockIdx.x * 1024 + 512 + tid] = ps1;
}
__device__ __forceinline__ void stage_hyena_filter_fin(const Params& p, int l, LAS unsigned char* lds) {
    const float* raw = (const float*)(p.ws + OFF_RAW); const float* part = (const float*)(p.ws + OFF_HPART); bf16_t* HR = (bf16_t*)(p.ws + OFF_HR);
    LAS float* tile = (LAS float*)lds; LAS float* red = tile + 64 * 65 + 64;
    const int tid = otid();
    LAS float* nall = red + 8 * 64;
    { float s0 = 0.f, s1 = 0.f;
#pragma unroll 8
      for (int b = 0; b < (int)gridDim.x; ++b) { s0 += part[(size_t)b * 1024 + tid]; s1 += part[(size_t)b * 1024 + 512 + tid]; }
      nall[tid] = 1.f / (s0 + s1 + 1e-6f); }
    __syncthreads();
    for (int u = blockIdx.x; u < (HRP / 64) * 8; u += gridDim.x) {
        const int cb = u & 7, ib = u >> 3, c0 = cb * 64, idx0 = ib * 64; const LAS float* nrm = nall + c0;
        for (int it = 0; it < 8; ++it) { const int e = tid + NT * it, il = e >> 6, c = e & 63, n = idx0 + il - HOFF; float v = 0.f;
            if (n <= 0 && -n < L) v = raw[(size_t)(-n) * 1024 + c0 + c]; else if (n > 0 && n < L) v = raw[(size_t)n * 1024 + 512 + c0 + c];
            tile[il * 65 + c] = v * nrm[c]; }
        __syncthreads();
        { const int c = tid >> 3, pc = tid & 7; const LAS float* s = tile + (8 * pc) * 65 + c;
          u32x4 o; o.x = pk2(s[0], s[65]); o.y = pk2(s[2 * 65], s[3 * 65]); o.z = pk2(s[4 * 65], s[5 * 65]); o.w = pk2(s[6 * 65], s[7 * 65]);
          *(u32x4*)(HR + (size_t)(c0 + c) * HRP + idx0 + 8 * pc) = o; }
        __syncthreads();
    }
}
__device__ __forceinline__ void hyena_prep_unit(const Params& p, int l, int seq, int unit, LAS unsigned char* lds) {
    const bf16_t* proj = (const bf16_t*)(p.ws + OFF_PROJ); bf16_t* UT = (bf16_t*)(p.ws + OFF_UT); bf16_t* X0T = (bf16_t*)(p.ws + OFF_X0T);
    const float* cw = p.in[I_HCW] + (size_t)l * 3 * 1536; const float* cb = p.in[I_HCB] + (size_t)l * 1536;
    LAS bf16_t* xs = (LAS bf16_t*)lds; LAS bf16_t* us = xs + 64 * 72;
    int tid_ = otid(); const int tid = tid_, cbk = unit & 7, tb = unit >> 3, c0 = cbk * 64, t0 = tb * 64, tl = tid >> 3, c8 = (tid & 7) * 8, t = t0 + tl;
    float x0[8], x1[8], vv[8];
#pragma unroll
    for (int j = 0; j < 8; ++j) { x0[j] = cb[c0 + c8 + j]; x1[j] = cb[512 + c0 + c8 + j]; vv[j] = cb[1024 + c0 + c8 + j]; }
    if (t < L) {
#pragma unroll
        for (int d = 0; d < 3; ++d) { const int tt = t + d - 1; if (tt < 0 || tt >= L) continue;
            const bf16_t* row = proj + (size_t)tt * PP + CB_X0 + c0 + c8; const u32x4 a = *(const u32x4*)row, b = *(const u32x4*)(row + 512), c = *(const u32x4*)(row + 1024);
            const float* w = cw + (size_t)d * 1536 + c0 + c8;
#pragma unroll
            for (int j = 0; j < 4; ++j) { x0[2 * j] += w[2 * j] * __uint_as_float(a[j] << 16); x0[2 * j + 1] += w[2 * j + 1] * __uint_as_float(a[j] & 0xffff0000u);
                x1[2 * j] += w[512 + 2 * j] * __uint_as_float(b[j] << 16); x1[2 * j + 1] += w[512 + 2 * j + 1] * __uint_as_float(b[j] & 0xffff0000u);
                vv[2 * j] += w[1024 + 2 * j] * __uint_as_float(c[j] << 16); vv[2 * j + 1] += w[1024 + 2 * j + 1] * __uint_as_float(c[j] & 0xffff0000u); } }
    } else {
#pragma unroll
        for (int j = 0; j < 8; ++j) { x0[j] = 0.f; x1[j] = 0.f; vv[j] = 0.f; } }
#pragma unroll
    for (int j = 0; j < 8; ++j) { xs[(c8 + j) * 72 + tl] = (bf16_t)f2bf(x0[j]); us[(c8 + j) * 72 + tl] = (bf16_t)f2bf(x1[j] * vv[j]); }
    __syncthreads();
    { const int c = tid >> 3, pc = tid & 7;
      *(u32x4*)(X0T + (size_t)(c0 + c) * LP + t0 + 8 * pc) = *(const LAS u32x4*)(xs + c * 72 + 8 * pc);
      *(u32x4*)(UT + (size_t)(c0 + c) * LP + t0 + 8 * pc) = *(const LAS u32x4*)(us + c * 72 + 8 * pc); }
    __syncthreads();
}
__device__ __forceinline__ void hyena_conv_unit(const Params& p, int l, int c, int sq0, LAS unsigned char* lds) {
    constexpr int NSEQ = 1;
    constexpr int NB = NB128, DC = 8, W = DC * 128 + 136, WP = 1168, WINB = 8 * WP * 2, NCHUNK = (2 * NB - 1 + DC - 1) / DC, NLD = (W + 7 + NT - 1) / NT;
    constexpr int SER_B = NB * 272, OFF_ZERO = NSEQ * SER_B, OFF_UM = OFF_ZERO + 272, OFF_WIN_ = OFF_UM + NSEQ * 64 + 16, OFF_RED = OFF_WIN_ + 2 * WINB, OFF_TILE = OFF_RED + 8 * 16 * NSEQ * 4;
    static_assert(OFF_WIN_ % 16 == 0 && OFF_TILE + 8 * 32 * 33 * 4 <= 160 * 1024, "hyena conv LDS map");
    const bf16_t* UT = (const bf16_t*)(p.ws + OFF_UT); const bf16_t* X0T = (const bf16_t*)(p.ws + OFF_X0T); const bf16_t* HRc = (const bf16_t*)(p.ws + OFF_HR) + (size_t)c * HRP;
    bf16_t* obuf = (bf16_t*)(p.ws + OFF_OBUF) + (size_t)sq0 * LP * DM;
    int tid_ = otid(); const int tid = tid_, wid = tid >> 6, lane = tid & 63, r = lane & 31, h = lane >> 5, mp = wid & 1, nt = wid >> 1, i0 = 32 * nt;
    LAS float* um = (LAS float*)(lds + OFF_UM); LAS float* red = (LAS float*)(lds + OFF_RED);
    const float dsk = p.in[I_HD][l * 512 + c];
    for (int s = 0; s < NSEQ; ++s) { const bf16_t* us = UT + ((size_t)s * 512 + c) * LP;
        for (int i = tid; i < SEQ / 8; i += NT) *(LAS u32x4*)(lds + s * SER_B + (i >> 4) * 272 + (i & 15) * 16) = *(const u32x4*)(us + 16 + 8 * i);
        if (tid < 16) um[s * 16 + tid] = bf2f(us[tid]); }
    if (tid < 68) *(LAS unsigned*)(lds + OFF_ZERO + tid * 4) = 0u;
    f32x16 acc[NSEQ][2];
#pragma unroll
    for (int s = 0; s < NSEQ; ++s)
#pragma unroll
        for (int mi = 0; mi < 2; ++mi)
#pragma unroll
            for (int i = 0; i < 16; ++i) acc[s][mi][i] = 0.f;
    { const int n0 = -(-(NB - 1) + DC) * 128; LAS bf16_t* wb = (LAS bf16_t*)(lds + OFF_WIN_);
      for (int e = tid; e < W + 7; e += NT) { const bf16_t v = HRc[n0 - 7 + e + HOFF];
#pragma unroll
          for (int a = 0; a < 8; ++a) { const int m = e + a - 7; if (m >= 0 && m < W) wb[a * WP + m] = v; } } }
    __syncthreads();
    for (int ci = 0; ci < NCHUNK; ++ci) {
        const int D0 = -(NB - 1) + DC * ci, n0 = -(D0 + DC) * 128;
        const LAS bf16_t* win = (const LAS bf16_t*)(lds + OFF_WIN_ + (ci & 1) * WINB);
        bf16_t pre[NLD];
        if (ci + 1 < NCHUNK) { const int n1 = n0 - DC * 128;
#pragma unroll
            for (int q = 0; q < NLD; ++q) { const int e = tid + NT * q; pre[q] = e < W + 7 ? HRc[n1 - 7 + e + HOFF] : (bf16_t)0; } }
        if (i0 < NB) {
            int dlo = D0, dhi = D0 + DC - 1;
            if (dlo < i0 - (NB - 1)) dlo = i0 - (NB - 1);
            if (dhi > i0 + 31) dhi = i0 + 31;
            if (dhi > NB - 1) dhi = NB - 1;
#pragma unroll 1
            for (int D = dlo; D <= dhi; ++D) {
                const int bi = i0 + r - D; const bool valid = bi >= 0 && bi < NB; const int a = r & 7;
                const LAS bf16_t* fa = win + a * WP + (8 * h - 64 * mp - r - D * 128 - n0 + a);
                const LAS unsigned char* fb = lds + (valid ? bi * 272 : OFF_ZERO) + 16 * h;
                bf16x8 F[10], G[8];
#pragma unroll
                for (int k = 0; k < 10; ++k) F[k] = *(const LAS bf16x8*)(fa + 16 * (k - 2));
#pragma unroll
                for (int ks = 0; ks < 8; ++ks) G[ks] = *(const LAS bf16x8*)(fb + 32 * ks);
#pragma unroll
                for (int ks = 0; ks < 8; ++ks) { acc[0][0] = MFMA32(F[ks + 2], G[ks], acc[0][0]); acc[0][1] = MFMA32(F[ks], G[ks], acc[0][1]); }
            }
        }
        if (ci + 1 < NCHUNK) { LAS bf16_t* wb = (LAS bf16_t*)(lds + OFF_WIN_ + ((ci + 1) & 1) * WINB);
#pragma unroll
            for (int q = 0; q < NLD; ++q) { const int e = tid + NT * q;
                if (e < W + 7) {
#pragma unroll
                    for (int a = 0; a < 8; ++a) { const int m = e + a - 7; if (m >= 0 && m < W) wb[a * WP + m] = pre[q]; } } } }
        __syncthreads();
    }
    LAS bf16_t* hs = (LAS bf16_t*)(lds + OFF_WIN_);
    static_assert((L + 16) * 2 <= 2 * WINB && L % 8 == 0 && HOFF % 8 == 0, "filter half fits the window buffers; 16-byte staging");
    for (int e = tid; e < (L + 16) / 8; e += NT) *(LAS u32x4*)(hs + 8 * e) = *(const u32x4*)(HRc + HOFF - L + 8 * e);
    __syncthreads();
    {
        LAS float* tl = (LAS float*)(lds + OFF_TILE) + wid * (32 * 33);
#pragma unroll
        for (int s = 0; s < NSEQ; ++s)
#pragma unroll
            for (int mi = 0; mi < 2; ++mi) {
                WAVE_SYNC();
#pragma unroll
                for (int i = 0; i < 16; ++i) tl[r * 33 + crow32(i, h)] = acc[s][mi][i];
                WAVE_SYNC();
                if (i0 < NB) {
                    const int mt = 2 * mp + mi; const bf16_t* x0p = X0T + ((size_t)s * 512 + c) * LP; bf16_t* op = obuf + (size_t)s * LP * DM + 512 + c;
#pragma unroll 1
                    for (int it = 0; it < 16; ++it) { const int e = lane + 64 * it, j = e & 31, b = e >> 5, blk = i0 + b;
                        if (blk < NB) { const int jj = 32 * mt + j, t = 16 + blk * 128 + jj; float y = tl[b * 33 + j]; const LAS bf16_t* hp = hs + (L - t);
#pragma unroll
                            for (int sm = 0; sm < 16; ++sm) y += bf2f(hp[sm]) * um[s * 16 + sm];
                            y += dsk * bf2f(*(const LAS bf16_t*)(lds + s * SER_B + blk * 272 + jj * 2));
                            op[(size_t)t * DM] = (bf16_t)f2bf(bf2f(x0p[t]) * y); } }
                }
            }
    }
    __syncthreads();
    for (int e = tid; e < (L + 16) / 8; e += NT) *(LAS u32x4*)(hs + 8 * e) = *(const u32x4*)(HRc + HOFF - 16 + 8 * e);
    __syncthreads();
    for (int s = 0; s < NSEQ; ++s) {
        float ya[16];
#pragma unroll
        for (int t = 0; t < 16; ++t) ya[t] = 0.f;
        for (int sp = tid; sp < L; sp += NT) { const float uv = sp < 16 ? um[s * 16 + sp] : bf2f(*(const LAS bf16_t*)(lds + s * SER_B + ((sp - 16) >> 7) * 272 + ((sp - 16) & 127) * 2));
            const LAS bf16_t* hp = hs + sp + 16;
#pragma unroll
            for (int t = 0; t < 16; ++t) ya[t] += bf2f(hp[-t]) * uv; }
#pragma unroll
        for (int t = 0; t < 16; ++t) { const float v = wave_sum(ya[t]); if (lane == 0) red[(s * 8 + wid) * 16 + t] = v; }
    }
    __syncthreads();
    if (tid < 16 * NSEQ) { const int s = tid >> 4, t = tid & 15; float y = 0.f; for (int w = 0; w < 8; ++w) y += red[(s * 8 + w) * 16 + t];
        y += dsk * um[s * 16 + t]; const float x0 = bf2f(X0T[((size_t)s * 512 + c) * LP + t]);
        obuf[((size_t)s * LP + t) * DM + 512 + c] = (bf16_t)f2bf(x0 * y); }
    __syncthreads();
}
__device__ __forceinline__ int ppos(int x) { const int w = x & 31; return (x & ~31) + 8 * ((w >> 2) & 3) + 4 * ((w >> 4) & 1) + (w & 3); }
__device__ __forceinline__ void hgrn2_prep_unit(const Params& p, int l, int unit, LAS unsigned char* lds) {
    const bf16_t* proj = (const bf16_t*)(p.ws + OFF_PROJ);
    int tid_ = otid(); const int tid = tid_, hd = unit & 3, n = unit >> 2, t0 = n * 64;
    LAS float* qs = (LAS float*)lds; LAS float* ks = qs + 64 * 129; LAS float* bs = ks + 64 * 129; LAS bf16_t* vs = (LAS bf16_t*)(bs + 64 * 129); LAS bf16_t* qh = vs + 128 * 72; LAS bf16_t* kh = qh + 16 * 136; LAS float* lbs = (LAS float*)(kh + 64 * 136);
    for (int dir = 0; dir < 2; ++dir) {
        unsigned char* img = p.ws + OFF_HGOPS + ((size_t)(n * 4 + hd) * 2 + dir) * HG_UNIT;
        if (tid < 128) { const float* lbp = p.in[I_HGLB] + dir * 512 + hd * 128 + tid; float se = 0.f, sl = 0.f;
            for (int q = 0; q < DEPTH; ++q) { const float e = __expf(lbp[q * 1024]); se += e; if (q >= 1 && q <= l) sl += e; }
            lbs[tid] = sl / se; }
        __syncthreads();
        { const int tl = tid >> 3, d16 = (tid & 7) * 16, t = t0 + tl, i = dir ? 63 - tl : tl;
          const bf16_t* row = proj + (size_t)t * PP + hd * 128 + d16;
#pragma unroll
          for (int hf = 0; hf < 2; ++hf) {
              u32x4 qv = {0u, 0u, 0u, 0u}, fv = qv, vv = qv;
              if (t < L) { qv = *(const u32x4*)(row + CC_Q + 8 * hf); fv = *(const u32x4*)(row + (dir ? CC_FB : CC_FF) + 8 * hf); vv = *(const u32x4*)(row + CC_I + 8 * hf); }
#pragma unroll
              for (int j = 0; j < 8; ++j) { const int d = d16 + 8 * hf + j; const unsigned sh = (j & 1) ? 0xffff0000u : 0u;
                  const float qx = (j & 1) ? __uint_as_float(qv[j >> 1] & 0xffff0000u) : __uint_as_float(qv[j >> 1] << 16);
                  const float fx = (j & 1) ? __uint_as_float(fv[j >> 1] & 0xffff0000u) : __uint_as_float(fv[j >> 1] << 16);
                  (void)sh; float g = 0.f, kk = 0.f, qq = 0.f;
                  if (t < L) {
                      const float lb = lbs[d], sg = sigmoidf_(fx), fg = lb + (1.f - lb) * sg;
                      g = __logf(fg); kk = (1.f - lb) * (1.f - sg); qq = siluf_(qx) * 0.08838834764831845f; }
                  qs[i * 129 + d] = qq; ks[i * 129 + d] = kk; bs[i * 129 + d] = g;
                  vs[d * 72 + i] = (bf16_t)((j & 1) ? (vv[j >> 1] >> 16) : (vv[j >> 1] & 0xffffu)); } } }
        __syncthreads();
        if (tid < 128) { float gv[64];
#pragma unroll
            for (int i = 0; i < 64; ++i) gv[i] = bs[i * 129 + tid];
#pragma unroll
            for (int i = 1; i < 64; ++i) gv[i] += gv[i - 1];
#pragma unroll
            for (int i = 0; i < 64; ++i) bs[i * 129 + tid] = gv[i]; }
        __syncthreads();
        { const int i = tid >> 3, d16 = (tid & 7) * 16; bf16_t* qrow = (bf16_t*)(img + HG_QT) + i * 136;
#pragma unroll
          for (int q4 = 0; q4 < 4; ++q4) { float v[4];
#pragma unroll
              for (int lo = 0; lo < 4; ++lo) { const int d = d16 + 4 * q4 + lo; v[lo] = qs[i * 129 + d] * __expf(bs[i * 129 + d]); }
              u32x2 w; w.x = pk2(v[0], v[1]); w.y = pk2(v[2], v[3]); *(u32x2*)(qrow + ppos(d16 + 4 * q4)) = w; } }
        { const int d = tid >> 2, j16 = (tid & 3) * 16; const float bl = bs[63 * 129 + d]; float v[16];
#pragma unroll
          for (int j = 0; j < 16; ++j) v[j] = ks[(j16 + j) * 129 + d] * __expf(bl - bs[(j16 + j) * 129 + d]);
          u32x4 w0, w1; w0.x = pk2(v[0], v[1]); w0.y = pk2(v[2], v[3]); w0.z = pk2(v[4], v[5]); w0.w = pk2(v[6], v[7]); w1.x = pk2(v[8], v[9]); w1.y = pk2(v[10], v[11]); w1.z = pk2(v[12], v[13]); w1.w = pk2(v[14], v[15]);
          bf16_t* krow = (bf16_t*)(img + HG_KT) + d * 72 + j16; *(u32x4*)krow = w0; *(u32x4*)(krow + 8) = w1;
          bf16_t* vrow = (bf16_t*)(img + HG_VT) + d * 72 + j16; *(u32x4*)vrow = *(const LAS u32x4*)(vs + d * 72 + j16); *(u32x4*)(vrow + 8) = *(const LAS u32x4*)(vs + d * 72 + j16 + 8);
          if (tid < 128) ((float*)(img + HG_D))[tid] = __expf(bs[63 * 129 + tid]); }
#pragma unroll 1
        for (int I = 0; I < 4; ++I) {
            __syncthreads();
            for (int e = tid; e < (16 + 16 * (I + 1)) * 128; e += NT) { const int row = e >> 7, d = e & 127; const float ref = I ? bs[(16 * I - 1) * 129 + d] : 0.f;
                if (row < 16) { const int i = 16 * I + row; qh[row * 136 + d] = (bf16_t)f2bf(qs[i * 129 + d] * __expf(bs[i * 129 + d] - ref)); }
                else { const int j = row - 16; kh[j * 136 + d] = (bf16_t)f2bf(ks[j * 129 + d] * __expf(fminf(ref - bs[j * 129 + d], 60.f))); } }
            __syncthreads();
            const int wid = tid >> 6, lane = tid & 63, r16 = lane & 15, q4 = lane >> 4;
            if (wid < 4) { f32x4 acc = {0.f, 0.f, 0.f, 0.f};
                if (wid <= I) {
#pragma unroll
                    for (int ks_ = 0; ks_ < 4; ++ks_) { const bf16x8 af = *(const LAS bf16x8*)(qh + r16 * 136 + 32 * ks_ + 8 * q4), bfr = *(const LAS bf16x8*)(kh + (16 * wid + r16) * 136 + 32 * ks_ + 8 * q4);
                        acc = MFMA16(af, bfr, acc); } }
                bf16_t* arow = (bf16_t*)(img + HG_A) + (16 * I + 4 * q4) * 72 + 16 * wid + r16;
#pragma unroll
                for (int j4 = 0; j4 < 4; ++j4) { const int i = 16 * I + 4 * q4 + j4, j = 16 * wid + r16; arow[j4 * 72] = (bf16_t)f2bf(j <= i ? acc[j4] : 0.f); } }
        }
        __syncthreads();
    }
}
__device__ __forceinline__ void gdn_prep_unit(const Params& p, int l, int unit, LAS unsigned char* lds) {
    const bf16_t* proj = (const bf16_t*)(p.ws + OFF_PROJ);
    int tid_ = otid(); const int tid = tid_, hd = unit & 3, n = unit >> 2, t0 = n * 64;
    LAS float* qs = (LAS float*)lds; LAS float* ks = qs + 64 * 131; LAS float* vs = ks + 64 * 131;
    LAS float* kk = vs + 64 * 131; LAS float* mtb = kk + 64 * 68; LAS float* qk = mtb + 64 * 68; LAS float* beta = qk + 64 * 68; LAS float* gg = beta + 128; LAS float* bc = gg + 128; LAS float* rf = bc + 128;
    const float* cwg = p.in[I_GCW] + (size_t)l * 3 * 1536; LAS float* cw = rf + 256;
    for (int e = tid; e < 3 * 384; e += NT) { const int dl = e / 384, c = e - dl * 384; cw[e] = cwg[(size_t)dl * 1536 + (c >> 7) * 512 + hd * 128 + (c & 127)]; }
    __syncthreads();
    { const int tl = tid >> 3, d16 = (tid & 7) * 16, t = t0 + tl; float q[16], k[16], v[16];
#pragma unroll
      for (int j = 0; j < 16; ++j) { q[j] = 0.f; k[j] = 0.f; v[j] = 0.f; }
      if (t < L) {
          u32x4 ra[3][2], rb[3][2], rc[3][2];
#pragma unroll
          for (int dlt = 0; dlt < 3; ++dlt) { const int tt = t + dlt - 1; const bool in = tt >= 0 && tt < L; const bf16_t* row = proj + (size_t)(in ? tt : t) * PP + CD_Q + hd * 128 + d16;
#pragma unroll
              for (int hf = 0; hf < 2; ++hf) { ra[dlt][hf] = *(const u32x4*)(row + 8 * hf); rb[dlt][hf] = *(const u32x4*)(row + 512 + 8 * hf); rc[dlt][hf] = *(const u32x4*)(row + 1024 + 8 * hf);
                  if (!in) { ra[dlt][hf] = (u32x4){0u, 0u, 0u, 0u}; rb[dlt][hf] = ra[dlt][hf]; rc[dlt][hf] = ra[dlt][hf]; } } }
#pragma unroll
          for (int dlt = 0; dlt < 3; ++dlt) { const LAS float* w = cw + dlt * 384 + d16;
#pragma unroll
              for (int hf = 0; hf < 2; ++hf) { const u32x4 a = ra[dlt][hf], b = rb[dlt][hf], c = rc[dlt][hf];
#pragma unroll
                  for (int j = 0; j < 4; ++j) { const int e = 8 * hf + 2 * j;
                      q[e] += w[e] * __uint_as_float(a[j] << 16); q[e + 1] += w[e + 1] * __uint_as_float(a[j] & 0xffff0000u);
                      k[e] += w[128 + e] * __uint_as_float(b[j] << 16); k[e + 1] += w[128 + e + 1] * __uint_as_float(b[j] & 0xffff0000u);
                      v[e] += w[256 + e] * __uint_as_float(c[j] << 16); v[e + 1] += w[256 + e + 1] * __uint_as_float(c[j] & 0xffff0000u); } } }
      }
      float sq = 0.f, sk = 0.f;
#pragma unroll
      for (int j = 0; j < 16; ++j) { q[j] = siluf_(q[j]); k[j] = siluf_(k[j]); v[j] = siluf_(v[j]); sq += q[j] * q[j]; sk += k[j] * k[j]; }
      sq += __shfl_xor(sq, 1); sq += __shfl_xor(sq, 2); sq += __shfl_xor(sq, 4); sk += __shfl_xor(sk, 1); sk += __shfl_xor(sk, 2); sk += __shfl_xor(sk, 4);
      const float rq = 1.f / sqrtf(sq + 1e-6f) * 0.08838834764831845f, rk = 1.f / sqrtf(sk + 1e-6f);
#pragma unroll
      for (int j = 0; j < 16; ++j) { qs[tl * 131 + d16 + j] = q[j] * rq; ks[tl * 131 + d16 + j] = k[j] * rk; vs[tl * 131 + d16 + j] = v[j]; } }
    if (tid < 128) { const int dir = tid >> 6, tl = tid & 63, t = t0 + tl; float be = 0.f, g = 0.f;
        if (t < L) { const bf16_t* row = proj + (size_t)t * PP; be = sigmoidf_(bf2f(row[(dir ? CD_BB : CD_BF) + hd]));
            const float x = bf2f(row[(dir ? CD_AB : CD_AF) + hd]) + p.in[I_GDT][(l * 2 + dir) * 4 + hd]; const float sp = x > 20.f ? x : log1pf(__expf(x));
            g = -__expf(p.in[I_GALOG][(l * 2 + dir) * 4 + hd]) * sp; }
        beta[dir * 64 + tl] = be; gg[dir * 64 + tl] = g; }
    __syncthreads();
    { int t2 = tid; OPAQUE(t2); const int i = t2 >> 3, j8 = (t2 & 7) * 8; float a[8], b[8];
#pragma unroll
      for (int j = 0; j < 8; ++j) { a[j] = 0.f; b[j] = 0.f; }
#pragma unroll 2
      for (int d = 0; d < 128; ++d) { const float ki = ks[i * 131 + d], qi = qs[i * 131 + d];
#pragma unroll
          for (int j = 0; j < 8; ++j) { const float kj = ks[(j8 + j) * 131 + d]; a[j] += ki * kj; b[j] += qi * kj; } }
#pragma unroll
      for (int j = 0; j < 8; ++j) { kk[i * 68 + j8 + j] = a[j]; qk[i * 68 + j8 + j] = b[j]; } }
    if (tid < 128) { const int d_ = tid >> 6, i = tid & 63; float a = gg[d_ * 64 + (d_ ? 63 - i : i)];
#pragma unroll
        for (int o = 1; o < 64; o <<= 1) { const float nb = __shfl_up(a, o); if (i >= o) a += nb; }
        bc[d_ * 64 + i] = a; }
    __syncthreads();
    if (tid < 256) { const int d_ = tid >> 7, ty = (tid >> 6) & 1, i = tid & 63, tl = d_ ? 63 - i : i; rf[(d_ * 2 + ty) * 64 + i] = beta[d_ * 64 + tl] * (ty ? __expf(bc[d_ * 64 + i]) : 1.f); }
    int t4 = tid; OPAQUE(t4); const int dir = t4 >> 8;
    unsigned char* img = p.ws + OFF_GDOPS + ((size_t)(n * 4 + hd) * 2 + dir) * GD_UNIT;
    { const int ht = t4 & 255; const float bl = bc[dir * 64 + 63];
      for (int e = ht; e < 64 * 32; e += 256) { const int i = e >> 5, d4 = (e & 31) * 4, tl = dir ? 63 - i : i; const float eb = __expf(bc[dir * 64 + i]);
          u32x2 w; w.x = pk2(qs[tl * 131 + d4] * eb, qs[tl * 131 + d4 + 1] * eb); w.y = pk2(qs[tl * 131 + d4 + 2] * eb, qs[tl * 131 + d4 + 3] * eb);
          *(u32x2*)((bf16_t*)(img + GD_QE) + i * 136 + ppos(d4)) = w; }
      for (int e = ht; e < 128 * 16; e += 256) { const int d = e >> 4, j4 = (e & 15) * 4; float v[4];
#pragma unroll
          for (int q = 0; q < 4; ++q) { const int j = j4 + q, tl = dir ? 63 - j : j; v[q] = ks[tl * 131 + d] * __expf(bl - bc[dir * 64 + j]); }
          u32x2 w; w.x = pk2(v[0], v[1]); w.y = pk2(v[2], v[3]); *(u32x2*)((bf16_t*)(img + GD_KDT) + d * 72 + ppos(j4)) = w; }
      for (int e = ht; e < 64 * 16; e += 256) { const int i = e >> 4, j4 = (e & 15) * 4, ti = dir ? 63 - i : i; float v[4];
#pragma unroll
          for (int q = 0; q < 4; ++q) { const int j = j4 + q, tj = dir ? 63 - j : j; v[q] = j <= i ? qk[ti * 68 + tj] * __expf(bc[dir * 64 + i] - bc[dir * 64 + j]) : 0.f; }
          u32x2 w; w.x = pk2(v[0], v[1]); w.y = pk2(v[2], v[3]); *(u32x2*)((bf16_t*)(img + GD_QK) + i * 72 + ppos(j4)) = w; }
      if (ht == 0) *(float*)(img + GD_BL) = __expf(bl); }
    __syncthreads();
    for (int e = tid; e < 4096; e += NT) { const int i = e >> 6, j = e & 63;
        mtb[i * 68 + j] = i > j ? beta[64 + 63 - i] * kk[(63 - i) * 68 + (63 - j)] * __expf(bc[64 + i] - bc[64 + j]) : 0.f; }
    __syncthreads();
    for (int e = tid; e < 4096; e += NT) { const int i = e >> 6, j = e & 63;
        kk[i * 68 + j] = i > j ? beta[i] * kk[i * 68 + j] * __expf(bc[i] - bc[j]) : 0.f; }
    __syncthreads();
    LAS float* TT0 = qk; LAS float* TT1 = qs;
    { const int d_ = tid >> 8, jc = (tid >> 2) & 63, part = tid & 3; const LAS float* M = d_ ? mtb : kk; LAS float* T = (d_ ? TT1 : TT0) + jc * 68;
        for (int i = 4 * part; i < 64; i += 16) *(LAS f32x4*)(T + i) = (f32x4){i == jc ? 1.f : 0.f, i + 1 == jc ? 1.f : 0.f, i + 2 == jc ? 1.f : 0.f, i + 3 == jc ? 1.f : 0.f};
        WAVE_SYNC();
#pragma unroll 1
        for (int i = 1; i < 64; ++i) { f32x4 s0 = {0.f, 0.f, 0.f, 0.f}; const LAS float* Mi = M + i * 68;
            if (i > jc) { for (int j = (jc & ~3) + 4 * part; j < i; j += 16) { const f32x4 m0 = *(const LAS f32x4*)(Mi + j), t0 = *(const LAS f32x4*)(T + j); s0 += m0 * t0; } }
            float s = (s0[0] + s0[1]) + (s0[2] + s0[3]); s += __shfl_xor(s, 1); s += __shfl_xor(s, 2);
            if (i > jc && part == 0) T[i] = -s;
            WAVE_SYNC(); } }
    __syncthreads();
    { int t3 = tid; OPAQUE(t3); const int dir = t3 >> 8, c = t3 & 255;
      unsigned char* img = p.ws + OFF_GDOPS + ((size_t)(n * 4 + hd) * 2 + dir) * GD_UNIT;
      const LAS float* src = (c < 128 ? vs + c : ks + (c - 128)) + (dir ? 63 * 131 : 0); const int step = dir ? -131 : 131;
      const LAS float* fac = rf + (dir * 2 + (c < 128 ? 0 : 1)) * 64; const LAS float* TT = dir ? TT1 : TT0;
      float x[64];
#pragma unroll
      for (int i = 0; i < 64; ++i) x[i] = 0.f;
#pragma unroll 2
      for (int j = 0; j < 64; ++j) { const float rj = fac[j] * src[j * step]; const LAS float* row = TT + j * 68;
#pragma unroll
          for (int i4 = 0; i4 < 16; ++i4) { const f32x4 m = *(const LAS f32x4*)(row + 4 * i4);
              x[4 * i4] += m[0] * rj; x[4 * i4 + 1] += m[1] * rj; x[4 * i4 + 2] += m[2] * rj; x[4 * i4 + 3] += m[3] * rj; } }
      if (c < 128) { bf16_t* urow = (bf16_t*)(img + GD_UT) + c * 72;
#pragma unroll
          for (int g8 = 0; g8 < 8; ++g8) { u32x4 w; w.x = pk2(x[8 * g8], x[8 * g8 + 1]); w.y = pk2(x[8 * g8 + 2], x[8 * g8 + 3]); w.z = pk2(x[8 * g8 + 4], x[8 * g8 + 5]); w.w = pk2(x[8 * g8 + 6], x[8 * g8 + 7]); *(u32x4*)(urow + 8 * g8) = w; }
      } else { bf16_t* wcol = (bf16_t*)(img + GD_W) + ppos(c - 128);
#pragma unroll
          for (int i = 0; i < 64; ++i) wcol[i * 136] = (bf16_t)f2bf(x[i]); } }
    __syncthreads();
}
__device__ __forceinline__ bf16x8 pack_tiles(const f32x4& a, const f32x4& b) { u32x4 w; w.x = pk2(a[0], a[1]); w.y = pk2(a[2], a[3]); w.z = pk2(b[0], b[1]); w.w = pk2(b[2], b[3]); return __builtin_bit_cast(bf16x8, w); }
template <bool GDN> __device__ __forceinline__ void scan_stream(const Params& p, int sid, LAS unsigned char* lds) {
    constexpr int UB = GDN ? GD_UNIT : HG_UNIT, NPC = UB / 16, NIT = (NPC + NT - 1) / NT;
    static_assert(UB % 16 == 0 && 2 * UB <= 160 * 1024, "scan image");
    int tid_ = otid(); const int hd = sid & 3, dir = sid >> 2, tid = tid_, wid = tid >> 6, lane = tid & 63, r16 = lane & 15, q4 = lane >> 4, dv0 = 16 * wid;
    const unsigned char* ops = p.ws + (GDN ? OFF_GDOPS : OFF_HGOPS) + ((size_t)hd * 2 + dir) * UB;
    float* osc = (float*)(p.ws + OFF_OSC) + (size_t)((GDN ? 2 : 0) + dir) * LP * 512;
    f32x4 S[8];
#pragma unroll
    for (int c = 0; c < 8; ++c) S[c] = (f32x4){0.f, 0.f, 0.f, 0.f};
    { const unsigned char* src = ops + (size_t)(dir ? NCH - 1 : 0) * 8 * UB;
#pragma unroll
      for (int it = 0; it < NIT; ++it) { const int pc = tid + NT * it; if (pc < NPC) *(LAS u32x4*)(lds + pc * 16) = *(const u32x4*)(src + pc * 16); } }
    __syncthreads();
    for (int k = 0; k < NCH; ++k) {
        const int n = dir ? NCH - 1 - k : k; LAS unsigned char* B = lds + (k & 1) * UB;
        if (k + 1 < NCH) { const unsigned char* src = ops + (size_t)(dir ? n - 1 : n + 1) * 8 * UB; LAS unsigned char* Bn = lds + ((k + 1) & 1) * UB;
#pragma unroll
            for (int it = 0; it < NIT; ++it) { const int pc = tid + NT * it; if (pc < NPC) __builtin_amdgcn_global_load_lds((const unsigned*)(src + pc * 16), (LAS unsigned*)(Bn + (pc - lane) * 16), 16, 0, 0); } }
        bf16x8 bS[4], bV[2];
#pragma unroll
        for (int ks = 0; ks < 4; ++ks) bS[ks] = pack_tiles(S[2 * ks], S[2 * ks + 1]);
        f32x4 O[4];
#pragma unroll
        for (int mt = 0; mt < 4; ++mt) O[mt] = (f32x4){0.f, 0.f, 0.f, 0.f};
        bf16x8 fa[16], fb[8];
        if constexpr (GDN) {
            f32x4 T[4]; u32x2 uu[4];
#pragma unroll
            for (int mt = 0; mt < 4; ++mt) T[mt] = (f32x4){0.f, 0.f, 0.f, 0.f};
#pragma unroll
            for (int ks = 0; ks < 4; ++ks)
#pragma unroll
                for (int mt = 0; mt < 4; ++mt) fa[4 * ks + mt] = *(const LAS bf16x8*)(B + GD_W + ((16 * mt + r16) * 136 + 32 * ks + 8 * q4) * 2);
#pragma unroll
            for (int mt = 0; mt < 4; ++mt) uu[mt] = *(const LAS u32x2*)(B + GD_UT + ((dv0 + r16) * 72 + 16 * mt + 4 * q4) * 2);
            __builtin_amdgcn_sched_barrier(0);
#pragma unroll
            for (int ks = 0; ks < 4; ++ks)
#pragma unroll
                for (int mt = 0; mt < 4; ++mt) T[mt] = MFMA16(fa[4 * ks + mt], bS[ks], T[mt]);
            __builtin_amdgcn_sched_barrier(0);
#pragma unroll
            for (int ks = 0; ks < 4; ++ks)
#pragma unroll
                for (int mt = 0; mt < 4; ++mt) fa[4 * ks + mt] = *(const LAS bf16x8*)(B + GD_QE + ((16 * mt + r16) * 136 + 32 * ks + 8 * q4) * 2);
            __builtin_amdgcn_sched_barrier(0);
#pragma unroll
            for (int ks = 0; ks < 4; ++ks)
#pragma unroll
                for (int mt = 0; mt < 4; ++mt) O[mt] = MFMA16(fa[4 * ks + mt], bS[ks], O[mt]);
            __builtin_amdgcn_sched_barrier(0);
#pragma unroll
            for (int ks = 0; ks < 2; ++ks)
#pragma unroll
                for (int mt = 0; mt < 4; ++mt) fa[4 * ks + mt] = *(const LAS bf16x8*)(B + GD_QK + ((16 * mt + r16) * 72 + 32 * ks + 8 * q4) * 2);
#pragma unroll
            for (int c = 0; c < 4; ++c)
#pragma unroll
                for (int ks = 0; ks < 2; ++ks) fb[2 * c + ks] = *(const LAS bf16x8*)(B + GD_KDT + ((16 * c + r16) * 72 + 32 * ks + 8 * q4) * 2);
            const float bl = *(const LAS float*)(B + GD_BL);
#pragma unroll
            for (int mt = 0; mt < 4; ++mt) { T[mt][0] = __uint_as_float(uu[mt].x << 16) - T[mt][0]; T[mt][1] = __uint_as_float(uu[mt].x & 0xffff0000u) - T[mt][1];
                T[mt][2] = __uint_as_float(uu[mt].y << 16) - T[mt][2]; T[mt][3] = __uint_as_float(uu[mt].y & 0xffff0000u) - T[mt][3]; }
            bV[0] = pack_tiles(T[0], T[1]); bV[1] = pack_tiles(T[2], T[3]);
#pragma unroll
            for (int c = 0; c < 8; ++c) S[c] = S[c] * bl;
            __builtin_amdgcn_sched_barrier(0);
#pragma unroll
            for (int ks = 0; ks < 2; ++ks)
#pragma unroll
                for (int mt = 0; mt < 4; ++mt) O[mt] = MFMA16(fa[4 * ks + mt], bV[ks], O[mt]);
#pragma unroll
            for (int c = 0; c < 4; ++c)
#pragma unroll
                for (int ks = 0; ks < 2; ++ks) S[c] = MFMA16(fb[2 * c + ks], bV[ks], S[c]);
            __builtin_amdgcn_sched_barrier(0);
#pragma unroll
            for (int c = 0; c < 4; ++c)
#pragma unroll
                for (int ks = 0; ks < 2; ++ks) fb[2 * c + ks] = *(const LAS bf16x8*)(B + GD_KDT + ((16 * (c + 4) + r16) * 72 + 32 * ks + 8 * q4) * 2);
            __builtin_amdgcn_sched_barrier(0);
#pragma unroll
            for (int c = 0; c < 4; ++c)
#pragma unroll
                for (int ks = 0; ks < 2; ++ks) S[c + 4] = MFMA16(fb[2 * c + ks], bV[ks], S[c + 4]);
        } else {
#pragma unroll
            for (int ks = 0; ks < 4; ++ks)
#pragma unroll
                for (int mt = 0; mt < 4; ++mt) fa[4 * ks + mt] = *(const LAS bf16x8*)(B + HG_QT + ((16 * mt + r16) * 136 + 32 * ks + 8 * q4) * 2);
#pragma unroll
            for (int ks = 0; ks < 2; ++ks) bV[ks] = *(const LAS bf16x8*)(B + HG_VT + ((dv0 + r16) * 72 + 32 * ks + 8 * q4) * 2);
#pragma unroll
            for (int ks = 0; ks < 2; ++ks)
#pragma unroll
                for (int mt = 0; mt < 4; ++mt) fb[4 * ks + mt] = *(const LAS bf16x8*)(B + HG_A + ((16 * mt + r16) * 72 + 32 * ks + 8 * q4) * 2);
            __builtin_amdgcn_sched_barrier(0);
#pragma unroll
            for (int ks = 0; ks < 4; ++ks)
#pragma unroll
                for (int mt = 0; mt < 4; ++mt) O[mt] = MFMA16(fa[4 * ks + mt], bS[ks], O[mt]);
#pragma unroll
            for (int ks = 0; ks < 2; ++ks)
#pragma unroll
                for (int mt = 0; mt < 4; ++mt) O[mt] = MFMA16(fb[4 * ks + mt], bV[ks], O[mt]);
            __builtin_amdgcn_sched_barrier(0);
#pragma unroll
            for (int c = 0; c < 8; ++c)
#pragma unroll
                for (int ks = 0; ks < 2; ++ks) fa[2 * c + ks] = *(const LAS bf16x8*)(B + HG_KT + ((16 * c + r16) * 72 + 32 * ks + 8 * q4) * 2);
#pragma unroll
            for (int c = 0; c < 8; ++c) { const f32x4 d4 = *(const LAS f32x4*)(B + HG_D + (16 * c + 4 * q4) * 4); S[c] = S[c] * d4; }
            __builtin_amdgcn_sched_barrier(0);
#pragma unroll
            for (int c = 0; c < 8; ++c)
#pragma unroll
                for (int ks = 0; ks < 2; ++ks) S[c] = MFMA16(fa[2 * c + ks], bV[ks], S[c]);
        }
        { float* ob = osc + (size_t)(64 * n) * 512 + hd * 128 + dv0 + r16;
#pragma unroll
          for (int mt = 0; mt < 4; ++mt)
#pragma unroll
              for (int j = 0; j < 4; ++j) { const int i = 16 * mt + 4 * q4 + j, tl = dir ? 63 - i : i; ob[tl * 512] = O[mt][j]; } }
        WAITCNT_VM(0);
        __syncthreads();
    }
}
__device__ __forceinline__ void stage_mixfin(const Params& p, int l, int seq) {
    const bf16_t* proj = (const bf16_t*)(p.ws + OFF_PROJ); bf16_t* obuf = (bf16_t*)(p.ws + OFF_OBUF) + (size_t)seq * LP * DM;
    const int lane = otid() & 63, gw = blockIdx.x * 8 + (otid() >> 6), NGW = gridDim.x * 8, e0 = lane * 8;
    const float lam_init = 0.8f - 0.6f * expf(-0.3f * (float)l);
    float lam; { const float a = p.in[I_LQ1][l * 64 + lane] * p.in[I_LK1][l * 64 + lane], b = p.in[I_LQ2][l * 64 + lane] * p.in[I_LK2][l * 64 + lane]; lam = expf(wave_sum(a)) - expf(wave_sum(b)) + lam_init; }
    float ng[3][8];
#pragma unroll
    for (int j = 0; j < 8; ++j) { ng[0][j] = p.in[I_HGNG][(size_t)l * 128 + (e0 & 127) + j]; ng[1][j] = p.in[I_GNG][(size_t)l * 128 + (e0 & 127) + j]; ng[2][j] = p.in[I_ANG][(size_t)l * 128 + (e0 & 127) + j] * (1.f - lam_init); }
    const float* osc = (const float*)(p.ws + OFF_OSC); const float* ao = (const float*)(p.ws + OFF_AO0);
    for (int t = gw; t < L; t += NGW) {
        f32x4 a[3][2], b[3][2]; u32x4 gv[2];
#pragma unroll
        for (int job = 0; job < 2; ++job) { const float* of = osc + (size_t)(2 * job) * LP * 512 + (size_t)t * 512 + e0; const float* ob = of + (size_t)LP * 512;
            a[job][0] = *(const f32x4*)of; a[job][1] = *(const f32x4*)(of + 4); b[job][0] = *(const f32x4*)ob; b[job][1] = *(const f32x4*)(ob + 4);
            gv[job] = *(const u32x4*)(proj + (size_t)t * PP + (job ? CD_Z : CC_G) + e0); }
        { const float* o0 = ao + (size_t)t * 512 + e0; const float* o1 = o0 + (size_t)LP * 512;
          a[2][0] = *(const f32x4*)o0; a[2][1] = *(const f32x4*)(o0 + 4); b[2][0] = *(const f32x4*)o1 * -lam; b[2][1] = *(const f32x4*)(o1 + 4) * -lam; }
#pragma unroll
        for (int job = 0; job < 3; ++job) { float o[8]; float ss = 0.f;
#pragma unroll
            for (int j = 0; j < 4; ++j) { o[j] = a[job][0][j] + b[job][0][j]; o[4 + j] = a[job][1][j] + b[job][1][j]; }
#pragma unroll
            for (int j = 0; j < 8; ++j) ss += o[j] * o[j];
            ss += __shfl_xor(ss, 1); ss += __shfl_xor(ss, 2); ss += __shfl_xor(ss, 4); ss += __shfl_xor(ss, 8);
            const float rinv = 1.f / sqrtf(ss * (1.f / 128.f) + RMS_EPS);
            u32x4 w;
            if (job < 2) {
#pragma unroll
                for (int j = 0; j < 4; ++j) { const float g0 = __uint_as_float(gv[job][j] << 16), g1 = __uint_as_float(gv[job][j] & 0xffff0000u);
                    w[j] = pk2(o[2 * j] * rinv * ng[job][2 * j] * siluf_(g0), o[2 * j + 1] * rinv * ng[job][2 * j + 1] * siluf_(g1)); }
                *(u32x4*)(obuf + (size_t)t * DM + 1024 + 512 * job + e0) = w;
            } else {
#pragma unroll
                for (int j = 0; j < 4; ++j) w[j] = pk2(o[2 * j] * rinv * ng[2][2 * j], o[2 * j + 1] * rinv * ng[2][2 * j + 1]);
                *(u32x4*)(obuf + (size_t)t * DM + e0) = w; } }
    }
}
__device__ __forceinline__ void stage_prep(const Params& p, int l, int seq, LAS unsigned char* lds, int qoff = 0) {
    constexpr int N_G = NCH * 4, N_H = NCH * 4, N_Y = (LP / 64) * 8, N_A = LP / 64, N_ALL = N_G + N_H + N_Y + N_A;
    unsigned* head = (unsigned*)(p.ws + OFF_CTL) + CW_QUEUE + 64 * (2 * DEPTH * NSEQ + l * NSEQ + seq + qoff);
    LAS int* slot = (LAS int*)(lds + LDS_BYTES - 32);
    for (;;) {
        __syncthreads();
        if (otid() == 0) *slot = (int)__hip_atomic_fetch_add(head, 1u, __ATOMIC_RELAXED, __HIP_MEMORY_SCOPE_AGENT);
        __syncthreads();
        const int u = *slot;
        if (u >= N_ALL) break;
        if (u < N_G) gdn_prep_unit(p, l, u, lds);
        else if (u < N_G + N_H) hgrn2_prep_unit(p, l, u - N_G, lds);
        else if (u < N_G + N_H + N_Y) hyena_prep_unit(p, l, seq, u - N_G - N_H, lds);
        else attn_prep_unit(p, u - N_G - N_H - N_Y, lds);
    }
}
__device__ __forceinline__ int q_fetch(unsigned* head, LAS int* slot) {
    __syncthreads();
    if (otid() == 0) *slot = (int)__hip_atomic_fetch_add(head, 1u, __ATOMIC_RELAXED, __HIP_MEMORY_SCOPE_AGENT);
    __syncthreads();
    return *slot;
}
__device__ __forceinline__ void stage_mix(const Params& p, int l, int seq, LAS unsigned char* lds, int qoff = 0, int mask = 7) {
    constexpr int NQB = (L + 255) / 256;
    unsigned* ctl = (unsigned*)(p.ws + OFF_CTL); const int ph = l * NSEQ + seq + qoff;
    unsigned* h_scan = ctl + CW_QUEUE + 64 * ph; unsigned* h_mix = ctl + CW_QUEUE2 + ph * 160;
    LAS int* slot = (LAS int*)(lds + LDS_BYTES - 32);
    for (int u; (u = q_fetch(h_scan, slot)) < 16;) { if (mask & 1) { if (u < 8) scan_stream<true>(p, u, lds); else scan_stream<false>(p, u - 8, lds); } }
    for (int k = 0; k < 8; ++k) { const int hm = (blockIdx.x + k) & 7;
        for (int q; (q = q_fetch(h_mix + 16 * hm, slot)) < NQB;) { if (mask & 2) attn_unit(p, q * 8 + hm, lds); } }
    for (int c; (c = q_fetch(h_mix + 16 * 8, slot)) < 512;) { if (mask & 4) hyena_conv_unit(p, l, c, seq, lds); }
}
#define XB_TMO      128
#define XB_XCNT(j)  (256  + 64 * (j))
#define XB_XSUB(j)  (1280 + 64 * (j))
#define XB_XGEN(j)  (2304 + 64 * (j))
#define XB_TOP      3328
#define XB_TOPGEN   3392
#define XCD_BAR_WORDS 3456
#ifdef HIPEMU
#define XB_SPIN_CAP (1u << 30)
#else
#define XB_SPIN_CAP (1u << 22)
#endif

__device__ __forceinline__ unsigned xb_ld(unsigned* p)              { return __hip_atomic_load(p, __ATOMIC_RELAXED, __HIP_MEMORY_SCOPE_AGENT); }
__device__ __forceinline__ unsigned xb_add(unsigned* p, unsigned v) { return __hip_atomic_fetch_add(p, v, __ATOMIC_RELAXED, __HIP_MEMORY_SCOPE_AGENT); }
__device__ __forceinline__ unsigned xb_xcc_id() { return (unsigned)__builtin_amdgcn_s_getreg((3 << 11) | 20) & 0xFu; }
#define XB_SPIN(cond, bar) do { unsigned _sp = 0; while (cond) { __builtin_amdgcn_s_sleep(1); \
    if ((++_sp & 255u) == 0u) { if (xb_ld(&(bar)[XB_TMO])) break; if (_sp > XB_SPIN_CAP) { atomicAdd(&(bar)[XB_TMO], 1u); break; } } } } while (0)

struct XcdBarrier {
    unsigned* bar; unsigned x;
    volatile LAS unsigned* st;
};

__device__ __forceinline__ XcdBarrier xcd_barrier_post(unsigned* bar, volatile LAS unsigned* st) {
    XcdBarrier b; b.bar = bar; b.x = xb_xcc_id(); b.st = st;
    if (threadIdx.x == 0) (void)xb_add(&bar[XB_XCNT(b.x)], 1u);
    return b;
}
__device__ __forceinline__ void xcd_barrier_complete(unsigned* bar, unsigned x, unsigned& nloc, unsigned& nx) {
    const unsigned G = gridDim.x * gridDim.y * gridDim.z;
    unsigned sum, cnt, mine, sp = 0u;
    for (;;) {
        sum = 0u; cnt = 0u; mine = 0u;
#pragma unroll
        for (unsigned j = 0; j < 16; ++j) { const unsigned c = xb_ld(&bar[XB_XCNT(j)]); sum += c; cnt += (c > 0u) ? 1u : 0u; mine = (j == x) ? c : mine; }
        if (sum == G) break;
        __builtin_amdgcn_s_sleep(1);
        if ((++sp & 255u) == 0u) { if (xb_ld(&bar[XB_TMO])) break; if (sp > XB_SPIN_CAP) { atomicAdd(&bar[XB_TMO], 1u); break; } }
    }
    nloc = mine > 0u ? mine : 1u; nx = cnt > 0u ? cnt : 1u;
}

__device__ __forceinline__ void xcd_barrier(const XcdBarrier& b) {
    WAITCNT_VM(0);
    __syncthreads();
    if (threadIdx.x == 0) {
        unsigned* bar = b.bar;
        WAITCNT_ALL();
        unsigned nloc = b.st[0], nx = b.st[1];
        if (nloc == 0u) { xcd_barrier_complete(bar, b.x, nloc, nx); b.st[0] = nloc; b.st[1] = nx; }
        const unsigned old = xb_add(&bar[XB_XSUB(b.x)], 1u);
        const unsigned gen = old / nloc;
        if (old + 1u == (gen + 1u) * nloc) {
            FENCE_RELEASE_AGENT();
            WAITCNT_VM(0);
            const unsigned og = xb_add(&bar[XB_TOP], 1u);
            const unsigned tg = og / nx;
            if (og + 1u == (tg + 1u) * nx) xb_add(&bar[XB_TOPGEN], 1u);
            else XB_SPIN(xb_ld(&bar[XB_TOPGEN]) == tg, bar);
            FENCE_ACQUIRE_AGENT();
            xb_add(&bar[XB_XGEN(b.x)], 1u);
            WAITCNT_VM(0);
        } else {
            XB_SPIN(xb_ld(&bar[XB_XGEN(b.x)]) == gen, bar);
            FENCE_ACQUIRE_AGENT();
            WAITCNT_VM(0);
        }
    }
    __syncthreads();
}

enum { ST_ROPE = 0, ST_EMBED, ST_CONVERT, ST_HYF_RAW, ST_HYF_FIN, ST_GEMM_IN, ST_PREP, ST_MIX, ST_MIXFIN, ST_GEMM_OUT, ST_LN1, ST_GEMM_UP, ST_FFNCONV, ST_GEMM_DOWN, ST_LN2, N_STAGES };

template <int ST> __device__ __forceinline__ void run_stage(const Params& p, int l, int seq, LAS unsigned char* lds) {
    if constexpr (ST == ST_ROPE) stage_rope(p);
    else if constexpr (ST == ST_EMBED) stage_embed(p);
    else if constexpr (ST == ST_CONVERT) stage_convert_weights(p, l, lds);
    else if constexpr (ST == ST_HYF_RAW) stage_hyena_filter_raw(p, l, lds);
    else if constexpr (ST == ST_HYF_FIN) stage_hyena_filter_fin(p, l, lds);
    else if constexpr (ST == ST_GEMM_IN) { EpiStoreBf16 E; E.O = (bf16_t*)(p.ws + OFF_PROJ); E.ldc = PP;
        stage_gemm(lds, (const bf16_t*)(p.ws + OFF_HBF) + (size_t)seq * LP * DM, (const bf16_t*)(p.ws + OFF_WIN), SEQ, PP, DM, E);
        tail_gemm<false>(p, (const bf16_t*)(p.ws + OFF_HBF) + ((size_t)seq * LP + SEQ) * DM, (const bf16_t*)(p.ws + OFF_WIN), PP, DM, E.O + (size_t)SEQ * PP, PP, seq, lds); }
    else if constexpr (ST == ST_PREP) stage_prep(p, l, seq, lds);
    else if constexpr (ST == ST_MIX) stage_mix(p, l, seq, lds);
    else if constexpr (ST == ST_MIXFIN) stage_mixfin(p, l, seq);
    else if constexpr (ST == ST_GEMM_OUT) {
        const float* lg = l ? p.in[I_LN2G] + (size_t)(l - 1) * DM : nullptr; const float* lb = l ? p.in[I_LN2B] + (size_t)(l - 1) * DM : nullptr;
        for (int s = 0; s < NSEQ; ++s) { EpiResid E; E.p = p; E.row_base = s * LP; E.ln_g = lg; E.ln_b = lb;
            stage_gemm(lds, (const bf16_t*)(p.ws + OFF_OBUF) + (size_t)s * LP * DM, (const bf16_t*)(p.ws + OFF_WOUT), SEQ, DM, DM, E);
            tail_gemm<true>(p, (const bf16_t*)(p.ws + OFF_OBUF) + ((size_t)s * LP + SEQ) * DM, (const bf16_t*)(p.ws + OFF_WOUT), DM, DM, nullptr, 0, s, lds, lg, lb); } }
    else if constexpr (ST == ST_LN1) stage_ln(p, l, 0);
    else if constexpr (ST == ST_GEMM_UP) { EpiStoreBf16 E; E.O = (bf16_t*)(p.ws + OFF_U); E.ldc = 2 * DFF;
        stage_gemm(lds, (const bf16_t*)(p.ws + OFF_HBF) + (size_t)seq * LP * DM, (const bf16_t*)(p.ws + OFF_WUP), SEQ, 2 * DFF, DM, E);
        tail_gemm<false>(p, (const bf16_t*)(p.ws + OFF_HBF) + ((size_t)seq * LP + SEQ) * DM, (const bf16_t*)(p.ws + OFF_WUP), 2 * DFF, DM, E.O + (size_t)SEQ * 2 * DFF, 2 * DFF, seq, lds); }
    else if constexpr (ST == ST_FFNCONV) stage_ffn_conv(p, l);
    else if constexpr (ST == ST_GEMM_DOWN) { EpiResid E; E.p = p; E.row_base = seq * LP; E.ln_g = p.in[I_LN1G] + (size_t)l * DM; E.ln_b = p.in[I_LN1B] + (size_t)l * DM;
        stage_gemm(lds, (const bf16_t*)(p.ws + OFF_ACT), (const bf16_t*)(p.ws + OFF_WDOWN), SEQ, DM, DFF, E);
        tail_gemm<true>(p, (const bf16_t*)(p.ws + OFF_ACT) + (size_t)SEQ * DFF, (const bf16_t*)(p.ws + OFF_WDOWN), DM, DFF, nullptr, 0, seq, lds, E.ln_g, E.ln_b); }
    else if constexpr (ST == ST_LN2) stage_ln(p, l, 1);
}
template <int ST> __global__ void __launch_bounds__(NT, 2) k_stage(Params p, int l, int seq) {
    DYN_LDS(lds);
    run_stage<ST>(p, l, seq, lds);
}


constexpr int LDS_XB = LDS_BYTES - 16;
template <int S> __device__ __forceinline__ void seq_mixers(const Params& p, int l, LAS unsigned char* lds, const XcdBarrier& bar) {
    if constexpr (S < NSEQ) {
        xcd_barrier(bar); run_stage<ST_GEMM_IN>(p, l, S, lds);
#ifdef PROBE_GEMM2
        xcd_barrier(bar); run_stage<ST_GEMM_IN>(p, l, S, lds);
#endif
        xcd_barrier(bar); run_stage<ST_PREP>(p, l, S, lds);
#ifdef PROBE_PREP2
        xcd_barrier(bar); stage_prep(p, l, S, lds, DEPTH * NSEQ);
#endif
        xcd_barrier(bar); run_stage<ST_MIX>(p, l, S, lds);
#ifdef PROBE_MIX2
        xcd_barrier(bar); stage_mix(p, l, S, lds, DEPTH * NSEQ, PROBE_MIX2);
#endif
        xcd_barrier(bar); run_stage<ST_MIXFIN>(p, l, S, lds);
        seq_mixers<S + 1>(p, l, lds, bar);
    }
}
template <int S> __device__ __forceinline__ void seq_ffn(const Params& p, int l, LAS unsigned char* lds, const XcdBarrier& bar) {
    if constexpr (S < NSEQ) {
        xcd_barrier(bar); run_stage<ST_GEMM_UP>(p, l, S, lds);
#ifdef PROBE_GEMM2
        xcd_barrier(bar); run_stage<ST_GEMM_UP>(p, l, S, lds);
#endif
        xcd_barrier(bar); run_stage<ST_FFNCONV>(p, l, S, lds);
        xcd_barrier(bar); run_stage<ST_GEMM_DOWN>(p, l, S, lds);
        seq_ffn<S + 1>(p, l, lds, bar);
    }
}
template <int LL> __device__ __forceinline__ void layer_body(const Params& p, LAS unsigned char* lds, const XcdBarrier& bar) {
    if constexpr (LL < DEPTH) {
        xcd_barrier(bar); run_stage<ST_HYF_FIN>(p, LL, 0, lds);
        seq_mixers<0>(p, LL, lds, bar);
        xcd_barrier(bar); run_stage<ST_GEMM_OUT>(p, LL, 0, lds);
        xcd_barrier(bar); run_stage<ST_LN1>(p, LL, 0, lds);
        seq_ffn<0>(p, LL, lds, bar);
        xcd_barrier(bar); run_stage<ST_LN2>(p, LL, 0, lds);
        if constexpr (LL + 1 < DEPTH) { run_stage<ST_CONVERT>(p, LL + 1, 0, lds); run_stage<ST_HYF_RAW>(p, LL + 1, 0, lds); }
        layer_body<LL + 1>(p, lds, bar);
    }
}
__global__ void __launch_bounds__(NT, 2) k_mega(Params p) {
    DYN_LDS(lds);
    if (threadIdx.x == 0) *(LAS u32x4*)(lds + LDS_XB) = (u32x4){0u, 0u, 0u, 0u};
    __syncthreads();
    XcdBarrier bar = xcd_barrier_post((unsigned*)(p.ws + OFF_CTL), (volatile LAS unsigned*)(lds + LDS_XB));
    run_stage<ST_ROPE>(p, 0, 0, lds); run_stage<ST_EMBED>(p, 0, 0, lds);
    run_stage<ST_CONVERT>(p, 0, 0, lds); run_stage<ST_HYF_RAW>(p, 0, 0, lds);
    layer_body<0>(p, lds, bar);
}

static int g_grid = 0;
extern "C" void kernel_launch(void* const* d_in, const int* in_sizes, int n_in, void* d_out, int out_size, void* d_ws, size_t ws_size, hipStream_t stream) {
    (void)in_sizes; (void)out_size;
    if (n_in != N_IN || ws_size < WS_NEED) { fprintf(stderr, "kernel_launch: bad inputs (n_in %d, ws %zu < %zu)\n", n_in, ws_size, (size_t)WS_NEED); return; }
    if (!g_grid) { int dev = 0, cus = 0, per_cu = 0; hipGetDevice(&dev); hipDeviceGetAttribute(&cus, hipDeviceAttributeMultiprocessorCount, dev);
        if (hipFuncSetAttribute((const void*)k_mega, hipFuncAttributeMaxDynamicSharedMemorySize, LDS_BYTES) != hipSuccess) { fprintf(stderr, "kernel_launch: hipFuncSetAttribute failed\n"); return; }
        if (hipOccupancyMaxActiveBlocksPerMultiprocessor(&per_cu, (const void*)k_mega, NT, LDS_BYTES) != hipSuccess || per_cu < 1) { fprintf(stderr, "kernel_launch: occupancy query failed (%d)\n", per_cu); return; }
        g_grid = cus > 0 ? cus : 256; }
    Params p{};
    for (int i = 0; i < N_IN; ++i) p.in[i] = (const float*)d_in[i];
    p.out = (float*)d_out; p.ws = (unsigned char*)d_ws;
    hipMemsetAsync((unsigned char*)d_ws + OFF_CTL, 0, CTL_ZERO_BYTES, stream);
    LAUNCH(k_mega, dim3(g_grid), dim3(NT), LDS_BYTES, stream, p);
}
```

```cpp
#ifdef HIPEMU
#include "hipemu.h"
#define LAS
#define WAITCNT_VM(n)
#define WAITCNT_LGKM(n)
#define WAVE_SYNC() hipemu::wave_rendezvous()
#define LAUNCH HIPEMU_LAUNCH
#define DYN_LDS(name) unsigned char* name = hipemu::cur->blk->lds
#define OPAQUE(v)
#define OPAQUE_S(v)
#define NT_STORE(ptr, val) (*(ptr) = (val))
#define MEMFENCE()
#define WAITCNT_ALL()
#define FENCE_RELEASE_AGENT() __atomic_thread_fence(__ATOMIC_SEQ_CST)
#define FENCE_ACQUIRE_AGENT() __atomic_thread_fence(__ATOMIC_SEQ_CST)
#else
#include <hip/hip_runtime.h>
#include <cstdio>
#include <cstdint>
#define LAS __attribute__((address_space(3)))
#define WAITCNT_VM(n) asm volatile("s_waitcnt vmcnt(" #n ")" ::: "memory")
#define WAITCNT_LGKM(n) asm volatile("s_waitcnt lgkmcnt(" #n ")" ::: "memory")
#define WAVE_SYNC() __builtin_amdgcn_wave_barrier()
#define LAUNCH(kernel, grid, block, ldsb, stream, ...) hipLaunchKernelGGL(kernel, grid, block, ldsb, stream, __VA_ARGS__)
#define OPAQUE(v) asm volatile("" : "+v"(v))
#define NT_STORE(ptr, val) __builtin_nontemporal_store((val), (ptr))
#define MEMFENCE() asm volatile("" ::: "memory")
#define OPAQUE_S(v) asm volatile("" : "+s"(v))
#define WAITCNT_ALL() __builtin_amdgcn_s_waitcnt(0)
#define FENCE_RELEASE_AGENT() __builtin_amdgcn_fence(__ATOMIC_RELEASE, "agent")
#define FENCE_ACQUIRE_AGENT() __builtin_amdgcn_fence(__ATOMIC_ACQUIRE, "agent")
#define DYN_LDS(name) extern __shared__ __attribute__((aligned(16))) unsigned char name##_raw[]; LAS unsigned char* name = (LAS unsigned char*)name##_raw
#endif
#include <cmath>

#ifdef HIPEMU
#ifndef CFG_SEQ
#define CFG_SEQ 256
#endif
#ifndef CFG_DEPTH
#define CFG_DEPTH 1
#endif
#ifndef CFG_DFF
#define CFG_DFF 512
#endif
constexpr int SEQ = CFG_SEQ, NSEQ = 2, DEPTH = CFG_DEPTH, DFF = CFG_DFF;
#else
constexpr int SEQ = 16384, NSEQ = 3, DEPTH = 4, DFF = 5632;
#endif
constexpr int DM = 2048, NMETA = 16, L = SEQ + NMETA, LP = (L + 255) / 256 * 256;
constexpr int DIN = 7696, PP = 7936;
static_assert(SEQ % 256 == 0, "full 256-row GEMM tiles cover the non-meta tokens; the 16 remaining rows go through tail_gemm");
constexpr int NCH = (L + 63) / 64;
constexpr int NB128 = SEQ / 128;
constexpr float LN_EPS = 1e-5f, RMS_EPS = 1e-6f;
constexpr int NT = 512;
constexpr int LDS_BYTES = 160 * 1024;
constexpr int CA_Q = 0, CA_K = 512, CA_V = 1024, CB_X0 = 1536, CB_X1 = 2048, CB_V = 2560;
constexpr int CC_Q = 3072, CC_FF = 3584, CC_FB = 4096, CC_I = 4608, CC_G = 5120;
constexpr int CD_Q = 5632, CD_K = 6144, CD_V = 6656, CD_Z = 7168, CD_BF = 7680, CD_BB = 7684, CD_AF = 7688, CD_AB = 7692;
enum { I_XP = 0, I_XS, I_META, I_EMBG, I_EMBB, I_WIN, I_LQ1, I_LK1, I_LQ2, I_LK2, I_ANG, I_HCW, I_HCB, I_HW1, I_HB1, I_HF1, I_HW2, I_HB2, I_HF2, I_HW3,
       I_HDEC, I_HD, I_HGLB, I_HGNG, I_GCW, I_GALOG, I_GDT, I_GNG, I_WOUT, I_LN1G, I_LN1B, I_WUP, I_FCW, I_FCB, I_WDOWN, I_LN2G, I_LN2B, N_IN };

typedef unsigned short bf16_t;
typedef short bf16x8 __attribute__((ext_vector_type(8)));
typedef float f32x4 __attribute__((ext_vector_type(4)));
typedef float f32x2_t __attribute__((ext_vector_type(2)));
typedef float f32x16 __attribute__((ext_vector_type(16)));
typedef unsigned u32x4 __attribute__((ext_vector_type(4)));
typedef unsigned u32x2 __attribute__((ext_vector_type(2)));

__host__ __device__ constexpr float alpha_of_depth() { return DEPTH == 4 ? 1.6817928305074290f : DEPTH == 1 ? 1.1892071150027210f : DEPTH == 2 ? 1.4142135623730951f : 1.5650845800732873f; }

constexpr size_t al256(size_t x) { return (x + 255) / 256 * 256; }
constexpr size_t OFF_CTL = 0, SZ_CTL = 1u << 20;
constexpr int CW_QUEUE = 8192, CTL_ZERO_BYTES = 65536;
constexpr size_t OFF_HMETA = OFF_CTL + SZ_CTL, SZ_HMETA = al256((size_t)NSEQ * NMETA * DM * 4);
constexpr size_t OFF_STATS = OFF_HMETA + SZ_HMETA, SZ_STATS = al256((size_t)NSEQ * L * 2 * 4);
constexpr size_t OFF_ROPE = OFF_STATS + SZ_STATS, SZ_ROPE = al256((size_t)L * 16 * 4);
constexpr size_t OFF_WIN = OFF_ROPE + SZ_ROPE, SZ_WIN = (size_t)PP * DM * 2;
constexpr size_t OFF_WOUT = OFF_WIN + SZ_WIN, SZ_WOUT = (size_t)DM * DM * 2;
constexpr size_t OFF_WUP = OFF_WOUT + SZ_WOUT, SZ_WUP = (size_t)2 * DFF * DM * 2;
constexpr size_t OFF_WDOWN = OFF_WUP + SZ_WUP, SZ_WDOWN = (size_t)DM * DFF * 2;
constexpr size_t OFF_HBF = OFF_WDOWN + SZ_WDOWN, SZ_HBF = (size_t)NSEQ * LP * DM * 2;
constexpr size_t OFF_OBUF = OFF_HBF + SZ_HBF, SZ_OBUF = SZ_HBF;
constexpr int HRP = (2 * L + 4096 + 63) / 64 * 64, HOFF = L + 2048;
constexpr size_t OFF_HR = OFF_OBUF + SZ_OBUF, SZ_HR = al256((size_t)512 * HRP * 2);
constexpr size_t OFF_HPART = OFF_HR + SZ_HR, SZ_HPART = al256((size_t)1024 * 1024 * 4);
constexpr size_t OFF_UT = OFF_HPART + SZ_HPART, SZ_UT = (size_t)512 * LP * 2;
constexpr size_t OFF_X0T = OFF_UT + SZ_UT, SZ_X0T = SZ_UT;
constexpr size_t OFF_SEQ = OFF_X0T + SZ_X0T;
constexpr size_t OFF_PROJ = OFF_SEQ, SZ_PROJ = (size_t)LP * PP * 2;
constexpr size_t OFF_QR = OFF_PROJ + SZ_PROJ, SZ_QR = (size_t)8 * LP * 64 * 2;
constexpr size_t OFF_KR = OFF_QR + SZ_QR, SZ_KR = SZ_QR;
constexpr size_t OFF_VT = OFF_KR + SZ_KR, SZ_VT = (size_t)4 * 128 * LP * 2;
constexpr int HG_QT = 0, HG_A = 17408, HG_KT = HG_A + 9216, HG_VT = HG_KT + 18432, HG_D = HG_VT + 18432, HG_UNIT = HG_D + 512;
constexpr int GD_W = 0, GD_QE = 17408, GD_QK = GD_QE + 17408, GD_KDT = GD_QK + 9216, GD_UT = GD_KDT + 18432, GD_BL = GD_UT + 18432, GD_UNIT = GD_BL + 256;
constexpr size_t OFF_HGOPS = OFF_VT + SZ_VT, SZ_HGOPS = (size_t)NCH * 8 * HG_UNIT;
constexpr size_t OFF_GDOPS = OFF_HGOPS + SZ_HGOPS, SZ_GDOPS = (size_t)NCH * 8 * GD_UNIT;
constexpr size_t OFF_OSC = OFF_GDOPS + SZ_GDOPS, SZ_OSC1 = (size_t)LP * 512 * 4;
constexpr size_t OFF_AO0 = OFF_OSC + 4 * SZ_OSC1, SZ_AO0 = (size_t)2 * LP * 512 * 4;
constexpr size_t OFF_SEQ_END = OFF_AO0 + SZ_AO0;
constexpr size_t OFF_RAW = OFF_HGOPS;
static_assert((size_t)L * 1024 * 4 <= SZ_HGOPS + SZ_GDOPS, "raw filter overlay");
constexpr size_t OFF_U = OFF_SEQ, SZ_U = (size_t)LP * 2 * DFF * 2;
constexpr size_t OFF_ACT = OFF_U + SZ_U, SZ_ACT = (size_t)LP * DFF * 2;
constexpr size_t WS_NEED = (OFF_SEQ_END > OFF_ACT + SZ_ACT ? OFF_SEQ_END : OFF_ACT + SZ_ACT);

struct Params { const float* in[N_IN]; float* out; unsigned char* ws; };

__device__ __forceinline__ int otid() { int t = threadIdx.x; OPAQUE(t); return t; }
__device__ __forceinline__ float bf2f(bf16_t b) { return __uint_as_float(((unsigned)b) << 16); }
__device__ __forceinline__ unsigned f2bf(float f) { unsigned u = __float_as_uint(f); return (u + 0x7fffu + ((u >> 16) & 1u)) >> 16; }
__device__ __forceinline__ unsigned pk2(float lo, float hi) {
#ifdef HIPEMU
    return f2bf(lo) | (f2bf(hi) << 16);
#else
    unsigned r; asm volatile("v_cvt_pk_bf16_f32 %0, %1, %2" : "=v"(r) : "v"(lo), "v"(hi)); return r;
#endif
}
__device__ __forceinline__ float wave_sum(float v) {
#pragma unroll
    for (int o = 1; o < 64; o <<= 1) v += __shfl_xor(v, o);
    return v;
}
__device__ __forceinline__ void sincos2pi(float f, float* s, float* c) {
#ifdef HIPEMU
    *s = (float)sin(6.283185307179586476925 * (double)f); *c = (float)cos(6.283185307179586476925 * (double)f);
#else
    *s = sinpif(2.f * f); *c = cospif(2.f * f);
#endif
}
__device__ __forceinline__ float fexp2(float x) { return __builtin_amdgcn_exp2f(x); }
__device__ __forceinline__ float sigmoidf_(float x) { return 1.f / (1.f + __expf(-x)); }
__device__ __forceinline__ float siluf_(float x) { return x / (1.f + __expf(-x)); }
__device__ __forceinline__ float* hrow(const Params& p, int seq, int t) {
    return t < NMETA ? (float*)(p.ws + OFF_HMETA) + ((size_t)seq * NMETA + t) * DM : p.out + ((size_t)seq * SEQ + (t - NMETA)) * DM;
}
namespace pg8 {
#define PG8_LAS LAS
typedef unsigned short bf16_t;
typedef short bf16x8 __attribute__((ext_vector_type(8)));
typedef float f32x4 __attribute__((ext_vector_type(4)));
typedef unsigned u32x4 __attribute__((ext_vector_type(4)));
constexpr int BM = 256, BK = 64, HALF = 128, HTB = HALF * BK * 2  , STAGE_BYTES = 8 * HTB, NXCD = 8, WGM = 8;

__host__ __device__ __forceinline__ int lds_byte(int r, int c) { const int st = (r >> 4) * 2 + (c >> 5), rr = r & 15, cc = c & 31, ob = rr * 64 + cc * 2; return st * 1024 + (ob ^ (((ob >> 9) & 1) << 5)); }
__host__ __device__ __forceinline__ void stage_rc(int b, int& R, int& C) { const int st = b / 1024, sb = b % 1024, swz = sb ^ (((sb >> 9) & 1) << 5); R = (st >> 1) * 16 + swz / 64; C = (st & 1) * 32 + (swz % 64) / 2; }
__host__ __device__ __forceinline__ int perm32(int rho) { const int n = rho >> 4, i = rho & 15; return 8 * (i >> 2) + 4 * n + (i & 3); }

struct Unit { int pm, pn; };
struct Gemm { const bf16_t* A; const bf16_t* Bt; int M, N, K; };

struct StaticOrder {
    int nM, nN, nwg, G, c;
    __host__ __device__ void init(int M, int N, int G_, int c_) { nM = M / BM; nN = N / BM; nwg = nM * nN; G = G_; c = c_; }
    __host__ __device__ bool next(int i, Unit& u) const {
        const long L = (long)i * G + c; if (L >= nwg) return false;
        int wgid = (int)L; { const int q = nwg / NXCD, r = nwg % NXCD, xcd = wgid % NXCD, off = wgid / NXCD; wgid = (xcd < r ? xcd * (q + 1) : r * (q + 1) + (xcd - r) * q) + off; }
        const int nig = WGM * nN, gid = wgid / nig, fm = gid * WGM, gsz = (nM - fm) < WGM ? (nM - fm) : WGM;
        u.pm = fm + ((wgid % nig) % gsz); u.pn = (wgid % nig) / gsz; return true;
    }
    __device__ __forceinline__ void a_ready(const Unit&) const {}
    __device__ __forceinline__ void done(const Unit&) const {}
};


template <class Epi, class Sched, bool ALIGN_EPI = false, bool SP2 = false>
__device__ __forceinline__ void gemm_phase(PG8_LAS unsigned char* lds, const Gemm g, const Sched& S, const Epi& E) {
    const int tid = otid(), wid = __builtin_amdgcn_readfirstlane(tid >> 6), lane = tid & 63, wr = wid >> 2, wc = wid & 3, fr = lane & 15, fq = lane >> 4;
    const int K = g.K, nt = K / BK;
    unsigned voffA[2], voffB[2];
#pragma unroll
    for (int i = 0; i < 2; ++i) { int R, C; stage_rc(tid * 16 + i * 8192, R, C); const int Rb = Epi::PERM ? ((R & ~31) + perm32(R & 31)) : R;
        voffA[i] = (unsigned)(R * K + C) * 2u; voffB[i] = (unsigned)(Rb * K + C) * 2u; }
    const size_t kstep = (size_t)(BK * 2);
    const size_t hstep = (size_t)HALF * K * 2;
    const size_t tstep = 2 * hstep;
    const unsigned ldsw = (unsigned)wid * 1024u;
    const int aoff = lds_byte(wr * 64 + fr, fq * 8), boff = lds_byte(wc * 32 + fr, fq * 8);
#define PG8_SA(b, h) (((b) * 2 + (h)) * HTB)
#define PG8_SB(b, h) ((4 + (b) * 2 + (h)) * HTB)
#define PG8_STAGE(bufoff, gbase, voff) do { _Pragma("unroll") for (int _i = 0; _i < 2; ++_i) \
        __builtin_amdgcn_global_load_lds((const unsigned*)((const char*)(gbase) + (voff)[_i]), (PG8_LAS unsigned*)(lds + (bufoff) + ldsw + _i * 8192), 16, 0, 0); } while (0)
#define PG8_LDA(dst, b, h) do { _Pragma("unroll") for (int m = 0; m < 4; ++m) _Pragma("unroll") for (int k = 0; k < 2; ++k) dst[m][k] = *(const PG8_LAS bf16x8*)(lds + PG8_SA(b, h) + aoff + m * 2048 + k * 1024); } while (0)
#define PG8_LDB(dst, b, h) do { _Pragma("unroll") for (int n = 0; n < 2; ++n) _Pragma("unroll") for (int k = 0; k < 2; ++k) dst[n][k] = *(const PG8_LAS bf16x8*)(lds + PG8_SB(b, h) + boff + n * 2048 + k * 1024); } while (0)
#define PG8_MMA(ai, bj, At, Bt) do { __builtin_amdgcn_s_setprio(1); _Pragma("unroll") for (int m = 0; m < 4; ++m) _Pragma("unroll") for (int n = 0; n < 2; ++n) _Pragma("unroll") for (int k = 0; k < 2; ++k) \
        acc[ai][bj][m][n] = __builtin_amdgcn_mfma_f32_16x16x32_bf16(Bt[n][k], At[m][k], acc[ai][bj][m][n], 0, 0, 0); __builtin_amdgcn_s_setprio(0); } while (0)
#define PG8_WAIT_V(n) WAITCNT_VM(n)
#define PG8_WAIT_L(n) WAITCNT_LGKM(n)
#define PG8_BAR __builtin_amdgcn_s_barrier()
#define PG8_SCHED __builtin_amdgcn_sched_barrier(0)
    Unit cur, nxt; int ui = 0;
    if (!S.next(0, cur)) return;
    f32x4 acc[2][2][4][2];
#pragma unroll
    for (int a = 0; a < 2; ++a)
#pragma unroll
        for (int b = 0; b < 2; ++b)
#pragma unroll
            for (int m = 0; m < 4; ++m)
#pragma unroll
                for (int n = 0; n < 2; ++n) acc[a][b][m][n] = (f32x4){0.f, 0.f, 0.f, 0.f};
    bf16x8 At[4][2], B0[2][2], B1[2][2];
    const char* cA = (const char*)g.A + (size_t)cur.pm * tstep; const char* cB = (const char*)g.Bt + (size_t)cur.pn * tstep;
    S.a_ready(cur);
    if constexpr (SP2) {
        PG8_STAGE(PG8_SB(0, 0), cB, voffB); PG8_STAGE(PG8_SB(0, 1), cB + hstep, voffB); PG8_STAGE(PG8_SA(0, 0), cA, voffA); PG8_STAGE(PG8_SA(0, 1), cA + hstep, voffA);
        if (wr == 1) PG8_BAR;
        PG8_WAIT_V(2); PG8_BAR;
        PG8_STAGE(PG8_SB(1, 0), cB + kstep, voffB); PG8_STAGE(PG8_SA(1, 0), cA + kstep, voffA); PG8_STAGE(PG8_SB(1, 1), cB + hstep + kstep, voffB);
        PG8_WAIT_V(6); PG8_BAR;
    } else {
        PG8_STAGE(PG8_SB(0, 0), cB, voffB); PG8_STAGE(PG8_SA(0, 0), cA, voffA); PG8_STAGE(PG8_SB(0, 1), cB + hstep, voffB); PG8_STAGE(PG8_SA(0, 1), cA + hstep, voffA);
        if (wr == 1) PG8_BAR;
        PG8_WAIT_V(4); PG8_BAR;
        PG8_STAGE(PG8_SB(1, 0), cB + kstep, voffB); PG8_STAGE(PG8_SA(1, 0), cA + kstep, voffA); PG8_STAGE(PG8_SB(1, 1), cB + hstep + kstep, voffB);
        PG8_WAIT_V(6); PG8_BAR;
    }
    for (;;) {
        const bool has_next = S.next(ui + 1, nxt);
        const char* nA = has_next ? (const char*)g.A + (size_t)nxt.pm * tstep : cA; const char* nB = has_next ? (const char*)g.Bt + (size_t)nxt.pn * tstep : cB;
        for (int t = 0; t < nt; t += 2) {
            const bool last = (t == nt - 2);
            const char* a1 = cA + (size_t)(t + 1) * kstep;
            const char* a2 = last ? nA : cA + (size_t)(t + 2) * kstep; const char* b2 = last ? nB : cB + (size_t)(t + 2) * kstep;
            const char* a3 = a2 + kstep; const char* b3 = b2 + kstep;
            if (last && has_next) S.a_ready(nxt);
            if constexpr (SP2) {
            PG8_LDB(B0, 0, 0); PG8_LDB(B1, 0, 1); PG8_SCHED; PG8_LDA(At, 0, 0); PG8_STAGE(PG8_SA(1, 1), a1 + hstep, voffA);
            PG8_WAIT_V(8); PG8_WAIT_L(0); PG8_BAR; PG8_MMA(0, 0, At, B0); PG8_MMA(0, 1, At, B1); PG8_BAR; PG8_SCHED;
            PG8_LDA(At, 0, 1); PG8_STAGE(PG8_SB(0, 0), b2, voffB); PG8_STAGE(PG8_SB(0, 1), b2 + hstep, voffB); PG8_STAGE(PG8_SA(0, 0), a2, voffA);
            PG8_WAIT_V(8); PG8_WAIT_L(0); PG8_BAR; PG8_MMA(1, 0, At, B0); PG8_MMA(1, 1, At, B1); PG8_BAR; PG8_SCHED;
            PG8_LDB(B0, 1, 0); PG8_LDB(B1, 1, 1); PG8_SCHED; PG8_LDA(At, 1, 0); PG8_STAGE(PG8_SA(0, 1), a2 + hstep, voffA);
            PG8_WAIT_V(8); PG8_WAIT_L(0); PG8_BAR; PG8_MMA(0, 0, At, B0); PG8_MMA(0, 1, At, B1); PG8_BAR; PG8_SCHED;
            PG8_LDA(At, 1, 1); PG8_STAGE(PG8_SB(1, 0), b3, voffB); PG8_STAGE(PG8_SB(1, 1), b3 + hstep, voffB); PG8_STAGE(PG8_SA(1, 0), a3, voffA);
            PG8_WAIT_V(8); PG8_WAIT_L(0); PG8_BAR; PG8_MMA(1, 0, At, B0); PG8_MMA(1, 1, At, B1); PG8_BAR; PG8_SCHED;
            } else {
            PG8_LDB(B0, 0, 0); PG8_SCHED; PG8_LDA(At, 0, 0); PG8_STAGE(PG8_SA(1, 1), a1 + hstep, voffA);
            PG8_WAIT_L(8); PG8_BAR; PG8_WAIT_L(0); PG8_MMA(0, 0, At, B0); PG8_BAR; PG8_SCHED;
            PG8_LDB(B1, 0, 1); PG8_STAGE(PG8_SB(0, 0), b2, voffB);
            PG8_BAR; PG8_WAIT_L(0); PG8_MMA(0, 1, At, B1); PG8_BAR;
            PG8_LDA(At, 0, 1); PG8_STAGE(PG8_SA(0, 0), a2, voffA);
            PG8_BAR; PG8_WAIT_L(0); PG8_MMA(1, 0, At, B0); PG8_BAR; PG8_SCHED;
            PG8_STAGE(PG8_SB(0, 1), b2 + hstep, voffB);
            PG8_WAIT_V(6); PG8_BAR; PG8_MMA(1, 1, At, B1); PG8_BAR;
            PG8_LDB(B0, 1, 0); PG8_SCHED; PG8_LDA(At, 1, 0); PG8_STAGE(PG8_SA(0, 1), a2 + hstep, voffA);
            PG8_WAIT_L(8); PG8_BAR; PG8_WAIT_L(0); PG8_MMA(0, 0, At, B0); PG8_BAR; PG8_SCHED;
            PG8_LDB(B1, 1, 1); PG8_STAGE(PG8_SB(1, 0), b3, voffB);
            PG8_BAR; PG8_WAIT_L(0); PG8_MMA(0, 1, At, B1); PG8_BAR;
            PG8_LDA(At, 1, 1); PG8_STAGE(PG8_SA(1, 0), a3, voffA);
            PG8_BAR; PG8_WAIT_L(0); PG8_MMA(1, 0, At, B0); PG8_BAR; PG8_SCHED;
            PG8_STAGE(PG8_SB(1, 1), b3 + hstep, voffB);
            PG8_WAIT_V(6); PG8_BAR; PG8_MMA(1, 1, At, B1); PG8_BAR;
            }
        }
        if constexpr (ALIGN_EPI) { if (wr == 0) PG8_BAR; }
        if constexpr (!Epi::AFTER_DRAIN) { E(acc, cur, wr, wc, fr, fq); S.done(cur); }
        if (!has_next) break;
#pragma unroll
        for (int a = 0; a < 2; ++a)
#pragma unroll
            for (int b = 0; b < 2; ++b)
#pragma unroll
                for (int m = 0; m < 4; ++m)
#pragma unroll
                    for (int n = 0; n < 2; ++n) acc[a][b][m][n] = (f32x4){0.f, 0.f, 0.f, 0.f};
        cur = nxt; cA = nA; cB = nB; ++ui;
        if constexpr (ALIGN_EPI) { if (wr == 1) PG8_BAR; }
    }
    PG8_WAIT_V(0);
    if constexpr (!ALIGN_EPI) { if (wr == 0) PG8_BAR; }
    PG8_BAR;
    if constexpr (Epi::AFTER_DRAIN) { E.fused(acc, cur, wr, wc, fr, fq, lds, wid, lane); S.done(cur); }
#undef PG8_SA
#undef PG8_SB
#undef PG8_STAGE
#undef PG8_LDA
#undef PG8_LDB
#undef PG8_MMA
#undef PG8_WAIT_V
#undef PG8_WAIT_L
#undef PG8_BAR
#undef PG8_SCHED
}
}

struct EpiStoreBf16 {
    static constexpr bool PERM = true, AFTER_DRAIN = false;
    bf16_t* O; int ldc;
    __device__ __forceinline__ void operator()(const pg8::f32x4 (&acc)[2][2][4][2], const pg8::Unit& u, int wr, int wc, int fr, int fq) const {
        const int row0 = u.pm * 256 + wr * 64 + fr, col0 = u.pn * 256 + wc * 32 + 8 * fq;
#pragma unroll
        for (int ai = 0; ai < 2; ++ai)
#pragma unroll
            for (int m = 0; m < 4; ++m) { bf16_t* rowp = O + (size_t)(row0 + ai * 128 + m * 16) * ldc + col0;
#pragma unroll
                for (int bj = 0; bj < 2; ++bj) { const pg8::f32x4 v0 = acc[ai][bj][m][0], v1 = acc[ai][bj][m][1];
                    u32x4 w; w.x = pk2(v0[0], v0[1]); w.y = pk2(v0[2], v0[3]); w.z = pk2(v1[0], v1[1]); w.w = pk2(v1[2], v1[3]);
                    NT_STORE((u32x4*)(rowp + bj * 128), w); } }
    }
};
struct EpiResid {
    static constexpr bool PERM = true, AFTER_DRAIN = false;
    Params p; int row_base; const float* ln_g; const float* ln_b;
    __device__ __forceinline__ void operator()(const pg8::f32x4 (&acc)[2][2][4][2], const pg8::Unit& u, int wr, int wc, int fr, int fq) const {
        const int row0 = row_base + u.pm * 256 + wr * 64 + fr, col0 = u.pn * 256 + wc * 32 + 8 * fq; const float al = alpha_of_depth();
        const float* stats = (const float*)(p.ws + OFF_STATS);
        f32x4 g0[2], g1[2], b0[2], b1[2];
        if (ln_g) {
#pragma unroll
            for (int bj = 0; bj < 2; ++bj) { g0[bj] = *(const f32x4*)(ln_g + col0 + bj * 128); g1[bj] = *(const f32x4*)(ln_g + col0 + bj * 128 + 4); b0[bj] = *(const f32x4*)(ln_b + col0 + bj * 128); b1[bj] = *(const f32x4*)(ln_b + col0 + bj * 128 + 4); } }
#pragma unroll
        for (int ai = 0; ai < 2; ++ai)
#pragma unroll
            for (int m = 0; m < 4; ++m) { const int R = row0 + ai * 128 + m * 16, seq = R / LP, t = R - seq * LP;
                if (t < L) { float* hp = hrow(p, seq, t) + col0; float mean = 0.f, rstd = 1.f;
                    if (ln_g) { mean = stats[2 * (seq * L + t)]; rstd = stats[2 * (seq * L + t) + 1]; }
#pragma unroll
                    for (int bj = 0; bj < 2; ++bj) { f32x4 h0 = *(f32x4*)(hp + bj * 128), h1 = *(f32x4*)(hp + bj * 128 + 4);
                        if (ln_g) { h0 = (h0 - mean) * rstd * g0[bj] + b0[bj]; h1 = (h1 - mean) * rstd * g1[bj] + b1[bj]; }
                        h0 = h0 * al + acc[ai][bj][m][0]; h1 = h1 * al + acc[ai][bj][m][1];
                        *(f32x4*)(hp + bj * 128) = h0; *(f32x4*)(hp + bj * 128 + 4) = h1; } } }
    }
};

__device__ __forceinline__ void stage_rope(const Params& p) {
    float* cs = (float*)(p.ws + OFF_ROPE);
    for (int idx = blockIdx.x * NT + otid(); idx < L * 8; idx += gridDim.x * NT) {
        const int t = idx >> 3, i = idx & 7;
        const double invs[8] = {1.0, 0.19392274474868576, 0.03760603093086393, 0.007292664737217109, 0.001414213562373095, 0.0002742481756762073, 5.318295896944988e-05, 1.031338537721246e-05};
        double inv = invs[0];
#pragma unroll
        for (int k = 1; k < 8; ++k) inv = i == k ? invs[k] : inv;
        const double x = (double)t * inv * 0.15915494309189533577; float sn, cn; sincos2pi((float)(x - floor(x)), &sn, &cn);
        cs[2 * idx] = cn; cs[2 * idx + 1] = sn;
    }
}
__device__ __forceinline__ void convert_tile(const float* W, int K, int N, bf16_t* WT, int unit, int nkb, LAS unsigned char* lds) {
    LAS float* tile = (LAS float*)lds;
    const int kb = unit % nkb, nb = unit / nkb, k0 = kb * 64, n0 = nb * 64, tid = otid();
    { const int kk = tid >> 4, n4 = (tid & 15) * 4;
#pragma unroll
      for (int h = 0; h < 2; ++h) { const int k = kk + 32 * h; f32x4 v = {0.f, 0.f, 0.f, 0.f};
          if (n0 + n4 < N) v = *(const f32x4*)(W + (size_t)(k0 + k) * N + n0 + n4);
          tile[k * 65 + n4] = v[0]; tile[k * 65 + n4 + 1] = v[1]; tile[k * 65 + n4 + 2] = v[2]; tile[k * 65 + n4 + 3] = v[3]; } }
    __syncthreads();
    { const int n = tid >> 3, pc = tid & 7; const LAS float* s = tile + (8 * pc) * 65 + n;
      u32x4 o; o.x = pk2(s[0], s[65]); o.y = pk2(s[2 * 65], s[3 * 65]); o.z = pk2(s[4 * 65], s[5 * 65]); o.w = pk2(s[6 * 65], s[7 * 65]);
      *(u32x4*)(WT + (size_t)(n0 + n) * K + k0 + 8 * pc) = o; }
    __syncthreads();
}
__device__ __forceinline__ void stage_convert_weights(const Params& p, int l, LAS unsigned char* lds) {
    constexpr int U_IN = (DM / 64) * (PP / 64), U_OUT = (DM / 64) * (DM / 64), U_UP = (DM / 64) * (2 * DFF / 64), U_DOWN = (DFF / 64) * (DM / 64);
    for (int u = blockIdx.x; u < U_IN + U_OUT + U_UP + U_DOWN; u += gridDim.x) {
        int r = u;
        if (r < U_IN) { convert_tile(p.in[I_WIN] + (size_t)l * DM * DIN, DM, DIN, (bf16_t*)(p.ws + OFF_WIN), r, DM / 64, lds); continue; } r -= U_IN;
        if (r < U_OUT) { convert_tile(p.in[I_WOUT] + (size_t)l * DM * DM, DM, DM, (bf16_t*)(p.ws + OFF_WOUT), r, DM / 64, lds); continue; } r -= U_OUT;
        if (r < U_UP) { convert_tile(p.in[I_WUP] + (size_t)l * DM * 2 * DFF, DM, 2 * DFF, (bf16_t*)(p.ws + OFF_WUP), r, DM / 64, lds); continue; } r -= U_UP;
        convert_tile(p.in[I_WDOWN] + (size_t)l * DFF * DM, DFF, DM, (bf16_t*)(p.ws + OFF_WDOWN), r, DFF / 64, lds);
    }
}
__device__ __forceinline__ void ln_row(f32x4 (&v)[8], const f32x4 (&gg)[8], const f32x4 (&bb)[8], float* of32, bf16_t* obf, int lane, float& mean_o, float& rstd_o) {
    float s = 0.f;
#pragma unroll
    for (int j = 0; j < 8; ++j) s += (v[j][0] + v[j][1]) + (v[j][2] + v[j][3]);
    const float mean = wave_sum(s) * (1.f / DM); float s2 = 0.f;
#pragma unroll
    for (int j = 0; j < 8; ++j) { v[j] = v[j] - mean; s2 += (v[j][0] * v[j][0] + v[j][1] * v[j][1]) + (v[j][2] * v[j][2] + v[j][3] * v[j][3]); }
    const float rstd = 1.f / sqrtf(wave_sum(s2) * (1.f / DM) + LN_EPS);
    mean_o = mean; rstd_o = rstd;
#pragma unroll
    for (int j = 0; j < 8; ++j) { const int c4 = lane + 64 * j;
        const f32x4 o = v[j] * rstd * gg[j] + bb[j]; if (of32) ((f32x4*)of32)[c4] = o;
        u32x2 w; w.x = pk2(o[0], o[1]); w.y = pk2(o[2], o[3]); ((u32x2*)obf)[c4] = w; }
}
__device__ __forceinline__ void stage_embed(const Params& p) {
    const int lane = otid() & 63, gw = blockIdx.x * 8 + (otid() >> 6), NGW = gridDim.x * 8;
    bf16_t* hbf = (bf16_t*)(p.ws + OFF_HBF);
    f32x4 gg[8], bb[8];
#pragma unroll
    for (int j = 0; j < 8; ++j) { gg[j] = ((const f32x4*)p.in[I_EMBG])[lane + 64 * j]; bb[j] = ((const f32x4*)p.in[I_EMBB])[lane + 64 * j]; }
    for (int r = gw; r < NSEQ * LP; r += NGW) {
        const int seq = r / LP, t = r - seq * LP; bf16_t* ob = hbf + (size_t)r * DM;
        if (t >= L) { for (int j = 0; j < 4; ++j) ((u32x4*)ob)[lane + 64 * j] = (u32x4){0u, 0u, 0u, 0u}; continue; }
        const float* src = t < NMETA ? p.in[I_META] + (size_t)t * DM : (seq < NSEQ - 1 ? p.in[I_XP] + ((size_t)seq * SEQ + (t - NMETA)) * DM : p.in[I_XS] + (size_t)(t - NMETA) * DM);
        f32x4 v[8];
#pragma unroll
        for (int j = 0; j < 8; ++j) v[j] = ((const f32x4*)src)[lane + 64 * j];
        float mu, rs; ln_row(v, gg, bb, hrow(p, seq, t), ob, lane, mu, rs);
    }
}
__device__ __forceinline__ void stage_ln(const Params& p, int l, int which) {
    const int lane = otid() & 63, gw = blockIdx.x * 8 + (otid() >> 6), NGW = gridDim.x * 8;
    bf16_t* hbf = (bf16_t*)(p.ws + OFF_HBF); float* stats = (float*)(p.ws + OFF_STATS);
    const float* g = p.in[which ? I_LN2G : I_LN1G] + (size_t)l * DM; const float* b = p.in[which ? I_LN2B : I_LN1B] + (size_t)l * DM;
    const bool last = which == 1 && l == DEPTH - 1;
    f32x4 gg[8], bb[8];
#pragma unroll
    for (int j = 0; j < 8; ++j) { gg[j] = ((const f32x4*)g)[lane + 64 * j]; bb[j] = ((const f32x4*)b)[lane + 64 * j]; }
    for (int r = gw; r < NSEQ * L; r += 2 * NGW) {
        const int r1 = r + NGW; const bool two = r1 < NSEQ * L;
        const int seq = r / L, t = r - seq * L, seq1 = two ? r1 / L : seq, t1 = two ? r1 - seq1 * L : t; float* hp = hrow(p, seq, t); float* hp1 = hrow(p, seq1, t1);
        f32x4 v[8], v1[8];
#pragma unroll
        for (int j = 0; j < 8; ++j) { v[j] = ((const f32x4*)hp)[lane + 64 * j]; v1[j] = ((const f32x4*)hp1)[lane + 64 * j]; }
        float mu, rs; ln_row(v, gg, bb, last ? hp : nullptr, hbf + ((size_t)seq * LP + t) * DM, lane, mu, rs);
        if (lane == 0) { stats[2 * r] = mu; stats[2 * r + 1] = rs; }
        if (two) { ln_row(v1, gg, bb, last ? hp1 : nullptr, hbf + ((size_t)seq1 * LP + t1) * DM, lane, mu, rs);
            if (lane == 0) { stats[2 * r1] = mu; stats[2 * r1 + 1] = rs; } }
    }
}
template <class Epi> __device__ __forceinline__ void stage_gemm(LAS unsigned char* lds, const bf16_t* A, const bf16_t* Bt, int M, int N, int K, const Epi& E) {
    pg8::Gemm g; g.A = A; g.Bt = Bt; g.M = M; g.N = N; g.K = K;
    pg8::StaticOrder S; S.init(M, N, gridDim.x, blockIdx.x);
    pg8::gemm_phase<Epi, pg8::StaticOrder, true, true>(lds, g, S, E);
    __syncthreads();
}

template <bool RESID> __device__ __forceinline__ void tail_gemm(const Params& p, const bf16_t* A, const bf16_t* Bt, int N, int K, bf16_t* O, int ldc, int seq, LAS unsigned char* lds, const float* ln_g = nullptr, const float* ln_b = nullptr) {
    const int tid = otid(), wid = tid >> 6, lane = tid & 63, r16 = lane & 15, q4 = lane >> 4; LAS f32x4* part = (LAS f32x4*)lds;
    for (int nt = blockIdx.x; nt < N / 16; nt += gridDim.x) {
        f32x4 acc = {0.f, 0.f, 0.f, 0.f};
        const bf16_t* ap = A + (size_t)r16 * K + 8 * q4 + 32 * wid; const bf16_t* bp = Bt + (size_t)(16 * nt + r16) * K + 8 * q4 + 32 * wid;
        const int nst = K / 256;
        for (int s0 = 0; s0 < nst; s0 += 4) { pg8::bf16x8 av[4], bv[4];
#pragma unroll
            for (int q = 0; q < 4; ++q) if (s0 + q < nst) { av[q] = *(const pg8::bf16x8*)(ap + 256 * (s0 + q)); bv[q] = *(const pg8::bf16x8*)(bp + 256 * (s0 + q)); }
#pragma unroll
            for (int q = 0; q < 4; ++q) if (s0 + q < nst) acc = __builtin_amdgcn_mfma_f32_16x16x32_bf16(av[q], bv[q], acc, 0, 0, 0); }
        __syncthreads();
        part[tid] = acc;
        __syncthreads();
        if (wid == 0) {
#pragma unroll
            for (int w = 1; w < 8; ++w) acc = acc + part[w * 64 + lane];
            const int col = 16 * nt + r16;
#pragma unroll
            for (int j = 0; j < 4; ++j) { const int t = SEQ + 4 * q4 + j;
                if constexpr (RESID) { float* hp = hrow(p, seq, t) + col; float hv = *hp;
                    if (ln_g) { const float* st = (const float*)(p.ws + OFF_STATS) + 2 * (seq * L + t); hv = (hv - st[0]) * st[1] * ln_g[col] + ln_b[col]; }
                    *hp = hv * alpha_of_depth() + acc[j]; }
                else O[(size_t)(4 * q4 + j) * ldc + col] = (bf16_t)f2bf(acc[j]); } }
    }
    __syncthreads();
}
__device__ __forceinline__ void stage_ffn_conv(const Params& p, int l) {
    const bf16_t* u = (const bf16_t*)(p.ws + OFF_U); bf16_t* act = (bf16_t*)(p.ws + OFF_ACT);
    const float* cw = p.in[I_FCW] + (size_t)l * 3 * 2 * DFF; const float* cb = p.in[I_FCB] + (size_t)l * 2 * DFF;
    constexpr int C8 = DFF / 8, R4 = LP / 4;
    for (long idx = (long)blockIdx.x * NT + otid(); idx < (long)R4 * C8; idx += (long)gridDim.x * NT) {
        const int t0 = (int)(idx / C8) * 4, c = (int)(idx % C8) * 8;
        if (t0 >= L) {
#pragma unroll
            for (int q = 0; q < 4; ++q) *(u32x4*)(act + (size_t)(t0 + q) * DFF + c) = (u32x4){0u, 0u, 0u, 0u};
            continue; }
        float wg[3][8], wv[3][8], bg[8], bv[8];
#pragma unroll
        for (int j = 0; j < 8; ++j) { bg[j] = cb[c + j]; bv[j] = cb[DFF + c + j];
#pragma unroll
            for (int d = 0; d < 3; ++d) { wg[d][j] = cw[(size_t)d * 2 * DFF + c + j]; wv[d][j] = cw[(size_t)d * 2 * DFF + DFF + c + j]; } }
        u32x4 ra[6], rb[6];
#pragma unroll
        for (int q = 0; q < 6; ++q) { const int tt = t0 + q - 1; ra[q] = (u32x4){0u, 0u, 0u, 0u}; rb[q] = ra[q];
            if (tt >= 0 && tt < L) { ra[q] = *(const u32x4*)(u + (size_t)tt * 2 * DFF + c); rb[q] = *(const u32x4*)(u + (size_t)tt * 2 * DFF + DFF + c); } }
#pragma unroll
        for (int q = 0; q < 4; ++q) { const int t = t0 + q; u32x4 o = {0u, 0u, 0u, 0u};
            if (t < L) { float g[8], v[8];
#pragma unroll
                for (int j = 0; j < 8; ++j) { g[j] = bg[j]; v[j] = bv[j]; }
#pragma unroll
                for (int d = 0; d < 3; ++d)
#pragma unroll
                    for (int j = 0; j < 4; ++j) { const unsigned a = ra[q + d][j], b = rb[q + d][j];
                        g[2 * j] += wg[d][2 * j] * __uint_as_float(a << 16); g[2 * j + 1] += wg[d][2 * j + 1] * __uint_as_float(a & 0xffff0000u);
                        v[2 * j] += wv[d][2 * j] * __uint_as_float(b << 16); v[2 * j + 1] += wv[d][2 * j + 1] * __uint_as_float(b & 0xffff0000u); }
#pragma unroll
                for (int j = 0; j < 4; ++j) o[j] = pk2(siluf_(g[2 * j]) * v[2 * j], siluf_(g[2 * j + 1]) * v[2 * j + 1]); }
            *(u32x4*)(act + (size_t)t * DFF + c) = o; }
    }
}
#define MFMA32(a, b, c) __builtin_amdgcn_mfma_f32_32x32x16_bf16((a), (b), (c), 0, 0, 0)
#define MFMA16(a, b, c) __builtin_amdgcn_mfma_f32_16x16x32_bf16((a), (b), (c), 0, 0, 0)
__device__ __forceinline__ int crow32(int i, int h) { return (i & 3) + 8 * (i >> 2) + 4 * h; }
__device__ __forceinline__ bf16x8 pack8(const f32x16& x, int s) {
    u32x4 p; p.x = pk2(x[8 * s], x[8 * s + 1]); p.y = pk2(x[8 * s + 2], x[8 * s + 3]); p.z = pk2(x[8 * s + 4], x[8 * s + 5]); p.w = pk2(x[8 * s + 6], x[8 * s + 7]);
    return __builtin_bit_cast(bf16x8, p);
}
__device__ __forceinline__ void attn_prep_unit(const Params& p, int unit, LAS unsigned char* lds) {
    const bf16_t* proj = (const bf16_t*)(p.ws + OFF_PROJ); bf16_t* Qr = (bf16_t*)(p.ws + OFF_QR); bf16_t* Kr = (bf16_t*)(p.ws + OFF_KR); bf16_t* Vt = (bf16_t*)(p.ws + OFF_VT);
    const float* cs = (const float*)(p.ws + OFF_ROPE);
    int tid_ = otid(); const int t0 = unit * 64, tid = tid_; LAS bf16_t* Vs = (LAS bf16_t*)lds;
    constexpr float QS = 0.125f * 1.4426950408889634f;
    for (int it = 0; it < 16; ++it) { const int idx = tid + NT * it, tl = idx >> 7, pc = idx & 127, t = t0 + tl, col8 = pc * 8, isk = col8 >= 512, cc = col8 & 511, map = cc >> 6, d0 = cc & 63;
        u32x4 o = {0u, 0u, 0u, 0u};
        if (t < L) { const u32x4 xv = *(const u32x4*)(proj + (size_t)t * PP + col8);
            if (d0 < 16) { const u32x4 yv = *(const u32x4*)(proj + (size_t)t * PP + (col8 ^ 8)); float x[8], y[8], r[8];
#pragma unroll
                for (int j = 0; j < 4; ++j) { x[2 * j] = __uint_as_float(xv[j] << 16); x[2 * j + 1] = __uint_as_float(xv[j] & 0xffff0000u); y[2 * j] = __uint_as_float(yv[j] << 16); y[2 * j + 1] = __uint_as_float(yv[j] & 0xffff0000u); }
#pragma unroll
                for (int j = 0; j < 8; ++j) { const float c = cs[(t * 8 + j) * 2], s = cs[(t * 8 + j) * 2 + 1]; r[j] = d0 == 0 ? x[j] * c - y[j] * s : x[j] * c + y[j] * s; if (!isk) r[j] *= QS; }
#pragma unroll
                for (int j = 0; j < 4; ++j) o[j] = pk2(r[2 * j], r[2 * j + 1]);
            } else if (isk) o = xv;
            else {
#pragma unroll
                for (int j = 0; j < 4; ++j) o[j] = pk2(__uint_as_float(xv[j] << 16) * QS, __uint_as_float(xv[j] & 0xffff0000u) * QS); } }
        *(u32x4*)((isk ? Kr : Qr) + ((size_t)map * LP + t) * 64 + d0) = o; }
    for (int it = 0; it < 8; ++it) { const int idx = tid + NT * it, tl = idx >> 6, pc = idx & 63, t = t0 + tl;
        u32x4 v = {0u, 0u, 0u, 0u}; if (t < L) v = *(const u32x4*)(proj + (size_t)t * PP + CA_V + pc * 8);
        *(LAS u32x4*)(Vs + tl * 520 + pc * 8) = v; }
    __syncthreads();
    for (int it = 0; it < 8; ++it) { const int idx = tid + NT * it, c = idx & 511, pp = idx >> 9, kb = pp >> 2, s = (pp >> 1) & 1, hh = pp & 1;
        unsigned short e[8];
#pragma unroll
        for (int a = 0; a < 2; ++a)
#pragma unroll
            for (int b = 0; b < 4; ++b) e[4 * a + b] = Vs[(32 * kb + 16 * s + 8 * a + 4 * hh + b) * 520 + c];
        u32x4 o; o.x = e[0] | ((unsigned)e[1] << 16); o.y = e[2] | ((unsigned)e[3] << 16); o.z = e[4] | ((unsigned)e[5] << 16); o.w = e[6] | ((unsigned)e[7] << 16);
        *(u32x4*)(Vt + (size_t)c * LP + t0 + 8 * pp) = o; }
    __syncthreads();
}
__device__ __forceinline__ void attn_unit(const Params& p, int unit, LAS unsigned char* lds) {
    const bf16_t* Qr = (const bf16_t*)(p.ws + OFF_QR); const bf16_t* Kr = (const bf16_t*)(p.ws + OFF_KR); const bf16_t* Vt = (const bf16_t*)(p.ws + OFF_VT);
    int tid_ = otid(); const int tid = tid_, wid = tid >> 6, lane = tid & 63, r = lane & 31, h = lane >> 5;
    const int hm = unit & 7, hd = hm >> 1, m = hm & 1, qb = unit >> 3, q0 = qb * 256 + wid * 32;
    constexpr int KB = 9216, VB = 18432, OFFV = 3 * KB, OFFS = 3 * KB + 2 * VB, NKT = (L + 63) / 64;
    LAS float* scr = (LAS float*)(lds + OFFS) + wid * 32;
    float* ao = (float*)(p.ws + OFF_AO0) + (size_t)m * LP * 512;
    const bf16_t* Qm = Qr + (size_t)(2 * hd + m) * LP * 64; const bf16_t* Km = Kr + (size_t)(2 * hd + m) * LP * 64; const bf16_t* Vh = Vt + (size_t)hd * 128 * LP;
    bf16x8 qf[4];
#pragma unroll
    for (int ks = 0; ks < 4; ++ks) qf[ks] = *(const bf16x8*)(Qm + (unsigned)((q0 + r) * 64 + 16 * ks + 8 * h));
    f32x16 z[4];
#pragma unroll
    for (int d = 0; d < 4; ++d)
#pragma unroll
        for (int i = 0; i < 16; ++i) z[d][i] = 0.f;
    float m_run = -INFINITY, l_run = 0.f;
    const int krow_ = tid >> 3, kpc = tid & 7;
    const unsigned koff = (unsigned)(krow_ * 64 + kpc * 8), voff = (unsigned)(krow_ * LP + kpc * 8);
    const unsigned kl = (unsigned)(krow_ * 144 + kpc * 16), vl = (unsigned)(OFFV + krow_ * 144 + kpc * 16);
    { const u32x4 k0 = *(const u32x4*)(Km + koff), v0 = *(const u32x4*)(Vh + voff), v1 = *(const u32x4*)(Vh + voff + 64u * LP);
      u32x4 k1 = {0u, 0u, 0u, 0u}; if (NKT > 1) k1 = *(const u32x4*)(Km + koff + 64u * 64u);
      *(LAS u32x4*)(lds + kl) = k0; *(LAS u32x4*)(lds + KB + kl) = k1; *(LAS u32x4*)(lds + vl) = v0; *(LAS u32x4*)(lds + vl + 64 * 144) = v1; }
    __syncthreads();
    f32x16 xc[2];
#pragma unroll
    for (int kb = 0; kb < 2; ++kb) {
#pragma unroll
        for (int i = 0; i < 16; ++i) xc[kb][i] = 0.f;
#pragma unroll
        for (int ks = 0; ks < 4; ++ks) { const bf16x8 a = *(const LAS bf16x8*)(lds + (32 * kb + r) * 144 + (16 * ks + 8 * h) * 2); xc[kb] = MFMA32(a, qf[ks], xc[kb]); } }
    int kslot = 0;
    for (int kt = 0; kt < NKT; ++kt) {
        const int ks1 = kslot == 2 ? 0 : kslot + 1, ks2 = ks1 == 2 ? 0 : ks1 + 1;
        LAS unsigned char* Vb = lds + OFFV + (kt & 1) * VB; LAS unsigned char* Kn = lds + ks1 * KB;
        u32x4 kreg = {0u, 0u, 0u, 0u}, vreg0 = kreg, vreg1 = kreg;
        if (kt + 2 < NKT) kreg = *(const u32x4*)(Km + koff + (unsigned)(kt + 2) * 4096u);
        if (kt + 1 < NKT) { const unsigned k1 = (unsigned)(kt + 1) * 64u; vreg0 = *(const u32x4*)(Vh + voff + k1); vreg1 = *(const u32x4*)(Vh + voff + 64u * LP + k1); }
        bf16x8 kf[8];
#pragma unroll
        for (int kb = 0; kb < 2; ++kb)
#pragma unroll
            for (int ks = 0; ks < 4; ++ks) kf[4 * kb + ks] = *(const LAS bf16x8*)(Kn + (32 * kb + r) * 144 + (16 * ks + 8 * h) * 2);
        __builtin_amdgcn_sched_barrier(0);
        if ((L & 63) != 0 && kt == NKT - 1) {
#pragma unroll
            for (int kb = 0; kb < 2; ++kb)
#pragma unroll
                for (int i = 0; i < 16; ++i) if (kt * 64 + 32 * kb + crow32(i, h) >= L) xc[kb][i] = -INFINITY; }
        float mx = xc[0][0];
#pragma unroll
        for (int kb = 0; kb < 2; ++kb)
#pragma unroll
            for (int i = 0; i < 16; ++i) mx = fmaxf(mx, xc[kb][i]);
        if (__any(mx > m_run + 8.f)) {
            const float mo = fmaxf(mx, __shfl_xor(mx, 32)), m_new = mo > m_run + 8.f ? mo : m_run, alpha = fexp2(m_run - m_new); m_run = m_new; l_run *= alpha;
            if (h == 0) scr[r] = alpha;
            WAVE_SYNC();
#pragma unroll
            for (int g = 0; g < 4; ++g) { const f32x4 af = *(const LAS f32x4*)(scr + 8 * g + 4 * h);
#pragma unroll
                for (int d = 0; d < 4; ++d)
#pragma unroll
                    for (int j = 0; j < 4; ++j) z[d][4 * g + j] *= af[j]; }
            WAVE_SYNC();
        }
        __builtin_amdgcn_sched_barrier(0);
        f32x16 xn[2];
#pragma unroll
        for (int kb = 0; kb < 2; ++kb) {
#pragma unroll
            for (int i = 0; i < 16; ++i) xn[kb][i] = 0.f;
#pragma unroll
            for (int ks = 0; ks < 4; ++ks) xn[kb] = MFMA32(kf[4 * kb + ks], qf[ks], xn[kb]); }
        bf16x8 vfa[8], vfb[8];
#pragma unroll
        for (int s2 = 0; s2 < 2; ++s2)
#pragma unroll
            for (int d = 0; d < 4; ++d) vfa[4 * s2 + d] = *(const LAS bf16x8*)(Vb + (32 * d + r) * 144 + (16 * s2 + 8 * h) * 2);
        __builtin_amdgcn_sched_barrier(0);
        float ps = 0.f;
#pragma unroll
        for (int kb = 0; kb < 2; ++kb)
#pragma unroll
            for (int i = 0; i < 16; ++i) { xc[kb][i] = fexp2(xc[kb][i] - m_run); ps += xc[kb][i]; }
        l_run += ps;
        bf16x8 pf[4];
#pragma unroll
        for (int kb = 0; kb < 2; ++kb)
#pragma unroll
            for (int s2 = 0; s2 < 2; ++s2) pf[2 * kb + s2] = pack8(xc[kb], s2);
        __builtin_amdgcn_sched_barrier(0);
#pragma unroll
        for (int s2 = 0; s2 < 2; ++s2)
#pragma unroll
            for (int d = 0; d < 4; ++d) vfb[4 * s2 + d] = *(const LAS bf16x8*)(Vb + (32 * d + r) * 144 + (32 + 16 * s2 + 8 * h) * 2);
#pragma unroll
        for (int s2 = 0; s2 < 2; ++s2)
#pragma unroll
            for (int d = 0; d < 4; ++d) z[d] = MFMA32(pf[s2], vfa[4 * s2 + d], z[d]);
        __builtin_amdgcn_sched_barrier(0);
#pragma unroll
        for (int s2 = 0; s2 < 2; ++s2)
#pragma unroll
            for (int d = 0; d < 4; ++d) z[d] = MFMA32(pf[2 + s2], vfb[4 * s2 + d], z[d]);
        if (kt + 2 < NKT) *(LAS u32x4*)(lds + ks2 * KB + kl) = kreg;
        if (kt + 1 < NKT) { const unsigned vn = (unsigned)(((kt + 1) & 1) * VB); *(LAS u32x4*)(lds + vn + vl) = vreg0; *(LAS u32x4*)(lds + vn + vl + 64 * 144) = vreg1; }
        __syncthreads();
        xc[0] = xn[0]; xc[1] = xn[1]; kslot = ks1;
    }
    l_run += __shfl_xor(l_run, 32);
    if (h == 0) scr[r] = 1.f / l_run;
    WAVE_SYNC();
    { unsigned ro = (unsigned)((q0 + 4 * h) * 512 + hd * 128 + r); OPAQUE(ro);
#pragma unroll
      for (int g = 0; g < 4; ++g) { const f32x4 af = *(const LAS f32x4*)(scr + 8 * g + 4 * h);
#pragma unroll
          for (int j = 0; j < 4; ++j)
#pragma unroll
              for (int d = 0; d < 4; ++d) ao[ro + (unsigned)(crow32(4 * g + j, 0) * 512 + 32 * d)] = z[d][4 * g + j] * af[j]; } }
    WAVE_SYNC();
}
__device__ __forceinline__ void stage_hyena_filter_raw(const Params& p, int l, LAS unsigned char* lds) {
    const float* w1 = p.in[I_HW1] + (size_t)l * 33 * 64; const float* b1 = p.in[I_HB1] + l * 64; const float* f1 = p.in[I_HF1] + l * 64;
    const float* w2 = p.in[I_HW2] + (size_t)l * 64 * 64; const float* b2 = p.in[I_HB2] + l * 64; const float* f2 = p.in[I_HF2] + l * 64;
    const float* w3 = p.in[I_HW3] + (size_t)l * 64 * 1024; const float* dec = p.in[I_HDEC] + (size_t)l * 1024;
    float* raw = (float*)(p.ws + OFF_RAW); float* part = (float*)(p.ws + OFF_HPART);
    LAS float* zs = (LAS float*)lds; LAS float* h1 = zs + 8 * 33; LAS float* h2 = h1 + 8 * 64;
    const int tid = otid(); float ps0 = 0.f, ps1 = 0.f;
    const float d0 = fabsf(dec[tid]), d1 = fabsf(dec[512 + tid]);
    for (int u = blockIdx.x; u < (L + 7) / 8; u += gridDim.x) {
        const int t0 = u * 8;
        if (tid < 8 * 33) { const int tl = tid / 33, e = tid - tl * 33, t = t0 + tl; float v;
            if (e == 0) v = (float)((double)t / (double)(L - 1));
            else { const int b = (e - 1) & 15; const double band = 1e-4 + (double)b * ((15.0 - 1e-4) / 15.0), x = (double)t * band / (double)L; float sn, cn; sincos2pi((float)(x - floor(x)), &sn, &cn);
                v = e <= 16 ? cn : -sn; }
            zs[tid] = v; }
        __syncthreads();
        { const int tl = tid >> 6, j = tid & 63; float s = b1[j];
#pragma unroll 3
          for (int e = 0; e < 33; ++e) s += zs[tl * 33 + e] * w1[e * 64 + j];
          h1[tid] = sinf(f1[j] * s); }
        __syncthreads();
        { const int tl = tid >> 6, j = tid & 63; float s = b2[j];
#pragma unroll 4
          for (int e = 0; e < 64; ++e) s += h1[tl * 64 + e] * w2[e * 64 + j];
          h2[tid] = sinf(f2[j] * s); }
        __syncthreads();
        float a0[8], a1[8];
#pragma unroll
        for (int i = 0; i < 8; ++i) { a0[i] = 0.f; a1[i] = 0.f; }
#pragma unroll 8
        for (int k = 0; k < 64; ++k) { const float wa = w3[k * 1024 + tid], wb = w3[k * 1024 + 512 + tid];
#pragma unroll
            for (int i = 0; i < 8; ++i) { const float hv = h2[i * 64 + k]; a0[i] += hv * wa; a1[i] += hv * wb; } }
#pragma unroll
        for (int i = 0; i < 8; ++i) { const int t = t0 + i; if (t < L) { const float tl = zs[i * 33];
            const float v0 = a0[i] * (expf(-tl * d0) + 0.05f), v1 = a1[i] * (expf(-tl * d1) + 0.05f);
            raw[(size_t)t * 1024 + tid] = v0; raw[(size_t)t * 1024 + 512 + tid] = v1; ps0 += fabsf(v0); ps1 += fabsf(v1); } }
        __syncthreads();
    }
    part[(size_t)blockIdx.x * 1024 + tid] = ps0; part[(size_t)blockIdx.x * 1024 + 512 + tid] = ps1;
}
__device__ __forceinline__ void stage_hyena_filter_fin(const Params& p, int l, LAS unsigned char* lds) {
    const float* raw = (const float*)(p.ws + OFF_RAW); const float* part = (const float*)(p.ws + OFF_HPART); bf16_t* HR = (bf16_t*)(p.ws + OFF_HR);
    LAS float* tile = (LAS float*)lds; LAS float* red = tile + 64 * 65 + 64;
    const int tid = otid();
    LAS float* nall = red + 8 * 64;
    { float s0 = 0.f, s1 = 0.f;
#pragma unroll 8
      for (int b = 0; b < (int)gridDim.x; ++b) { s0 += part[(size_t)b * 1024 + tid]; s1 += part[(size_t)b * 1024 + 512 + tid]; }
      nall[tid] = 1.f / (s0 + s1 + 1e-6f); }
    __syncthreads();
    for (int u = blockIdx.x; u < (HRP / 64) * 8; u += gridDim.x) {
        const int cb = u & 7, ib = u >> 3, c0 = cb * 64, idx0 = ib * 64; const LAS float* nrm = nall + c0;
        for (int it = 0; it < 8; ++it) { const int e = tid + NT * it, il = e >> 6, c = e & 63, n = idx0 + il - HOFF; float v = 0.f;
            if (n <= 0 && -n < L) v = raw[(size_t)(-n) * 1024 + c0 + c]; else if (n > 0 && n < L) v = raw[(size_t)n * 1024 + 512 + c0 + c];
            tile[il * 65 + c] = v * nrm[c]; }
        __syncthreads();
        { const int c = tid >> 3, pc = tid & 7; const LAS float* s = tile + (8 * pc) * 65 + c;
          u32x4 o; o.x = pk2(s[0], s[65]); o.y = pk2(s[2 * 65], s[3 * 65]); o.z = pk2(s[4 * 65], s[5 * 65]); o.w = pk2(s[6 * 65], s[7 * 65]);
          *(u32x4*)(HR + (size_t)(c0 + c) * HRP + idx0 + 8 * pc) = o; }
        __syncthreads();
    }
}
__device__ __forceinline__ void hyena_prep_unit(const Params& p, int l, int seq, int unit, LAS unsigned char* lds) {
    const bf16_t* proj = (const bf16_t*)(p.ws + OFF_PROJ); bf16_t* UT = (bf16_t*)(p.ws + OFF_UT); bf16_t* X0T = (bf16_t*)(p.ws + OFF_X0T);
    const float* cw = p.in[I_HCW] + (size_t)l * 3 * 1536; const float* cb = p.in[I_HCB] + (size_t)l * 1536;
    LAS bf16_t* xs = (LAS bf16_t*)lds; LAS bf16_t* us = xs + 64 * 72;
    int tid_ = otid(); const int tid = tid_, cbk = unit & 7, tb = unit >> 3, c0 = cbk * 64, t0 = tb * 64, tl = tid >> 3, c8 = (tid & 7) * 8, t = t0 + tl;
    float x0[8], x1[8], vv[8];
#pragma unroll
    for (int j = 0; j < 8; ++j) { x0[j] = cb[c0 + c8 + j]; x1[j] = cb[512 + c0 + c8 + j]; vv[j] = cb[1024 + c0 + c8 + j]; }
    if (t < L) {
#pragma unroll
        for (int d = 0; d < 3; ++d) { const int tt = t + d - 1; if (tt < 0 || tt >= L) continue;
            const bf16_t* row = proj + (size_t)tt * PP + CB_X0 + c0 + c8; const u32x4 a = *(const u32x4*)row, b = *(const u32x4*)(row + 512), c = *(const u32x4*)(row + 1024);
            const float* w = cw + (size_t)d * 1536 + c0 + c8;
#pragma unroll
            for (int j = 0; j < 4; ++j) { x0[2 * j] += w[2 * j] * __uint_as_float(a[j] << 16); x0[2 * j + 1] += w[2 * j + 1] * __uint_as_float(a[j] & 0xffff0000u);
                x1[2 * j] += w[512 + 2 * j] * __uint_as_float(b[j] << 16); x1[2 * j + 1] += w[512 + 2 * j + 1] * __uint_as_float(b[j] & 0xffff0000u);
                vv[2 * j] += w[1024 + 2 * j] * __uint_as_float(c[j] << 16); vv[2 * j + 1] += w[1024 + 2 * j + 1] * __uint_as_float(c[j] & 0xffff0000u); } }
    } else {
#pragma unroll
        for (int j = 0; j < 8; ++j) { x0[j] = 0.f; x1[j] = 0.f; vv[j] = 0.f; } }
#pragma unroll
    for (int j = 0; j < 8; ++j) { xs[(c8 + j) * 72 + tl] = (bf16_t)f2bf(x0[j]); us[(c8 + j) * 72 + tl] = (bf16_t)f2bf(x1[j] * vv[j]); }
    __syncthreads();
    { const int c = tid >> 3, pc = tid & 7;
      *(u32x4*)(X0T + (size_t)(c0 + c) * LP + t0 + 8 * pc) = *(const LAS u32x4*)(xs + c * 72 + 8 * pc);
      *(u32x4*)(UT + (size_t)(c0 + c) * LP + t0 + 8 * pc) = *(const LAS u32x4*)(us + c * 72 + 8 * pc); }
    __syncthreads();
}
__device__ __forceinline__ void hyena_conv_unit(const Params& p, int l, int c, int sq0, LAS unsigned char* lds) {
    constexpr int NSEQ = 1;
    constexpr int NB = NB128, DC = 8, W = DC * 128 + 136, WP = 1168, WINB = 8 * WP * 2, NCHUNK = (2 * NB - 1 + DC - 1) / DC, NLD = (W + 7 + NT - 1) / NT;
    constexpr int SER_B = NB * 272, OFF_ZERO = NSEQ * SER_B, OFF_UM = OFF_ZERO + 272, OFF_WIN_ = OFF_UM + NSEQ * 64 + 16, OFF_RED = OFF_WIN_ + 2 * WINB, OFF_TILE = OFF_RED + 8 * 16 * NSEQ * 4;
    static_assert(OFF_WIN_ % 16 == 0 && OFF_TILE + 8 * 32 * 33 * 4 <= 160 * 1024, "hyena conv LDS map");
    const bf16_t* UT = (const bf16_t*)(p.ws + OFF_UT); const bf16_t* X0T = (const bf16_t*)(p.ws + OFF_X0T); const bf16_t* HRc = (const bf16_t*)(p.ws + OFF_HR) + (size_t)c * HRP;
    bf16_t* obuf = (bf16_t*)(p.ws + OFF_OBUF) + (size_t)sq0 * LP * DM;
    int tid_ = otid(); const int tid = tid_, wid = tid >> 6, lane = tid & 63, r = lane & 31, h = lane >> 5, mp = wid & 1, nt = wid >> 1, i0 = 32 * nt;
    LAS float* um = (LAS float*)(lds + OFF_UM); LAS float* red = (LAS float*)(lds + OFF_RED);
    const float dsk = p.in[I_HD][l * 512 + c];
    for (int s = 0; s < NSEQ; ++s) { const bf16_t* us = UT + ((size_t)s * 512 + c) * LP;
        for (int i = tid; i < SEQ / 8; i += NT) *(LAS u32x4*)(lds + s * SER_B + (i >> 4) * 272 + (i & 15) * 16) = *(const u32x4*)(us + 16 + 8 * i);
        if (tid < 16) um[s * 16 + tid] = bf2f(us[tid]); }
    if (tid < 68) *(LAS unsigned*)(lds + OFF_ZERO + tid * 4) = 0u;
    f32x16 acc[NSEQ][2];
#pragma unroll
    for (int s = 0; s < NSEQ; ++s)
#pragma unroll
        for (int mi = 0; mi < 2; ++mi)
#pragma unroll
            for (int i = 0; i < 16; ++i) acc[s][mi][i] = 0.f;
    { const int n0 = -(-(NB - 1) + DC) * 128; LAS bf16_t* wb = (LAS bf16_t*)(lds + OFF_WIN_);
      for (int e = tid; e < W + 7; e += NT) { const bf16_t v = HRc[n0 - 7 + e + HOFF];
#pragma unroll
          for (int a = 0; a < 8; ++a) { const int m = e + a - 7; if (m >= 0 && m < W) wb[a * WP + m] = v; } } }
    __syncthreads();
    for (int ci = 0; ci < NCHUNK; ++ci) {
        const int D0 = -(NB - 1) + DC * ci, n0 = -(D0 + DC) * 128;
        const LAS bf16_t* win = (const LAS bf16_t*)(lds + OFF_WIN_ + (ci & 1) * WINB);
        bf16_t pre[NLD];
        if (ci + 1 < NCHUNK) { const int n1 = n0 - DC * 128;
#pragma unroll
            for (int q = 0; q < NLD; ++q) { const int e = tid + NT * q; pre[q] = e < W + 7 ? HRc[n1 - 7 + e + HOFF] : (bf16_t)0; } }
        if (i0 < NB) {
            int dlo = D0, dhi = D0 + DC - 1;
            if (dlo < i0 - (NB - 1)) dlo = i0 - (NB - 1);
            if (dhi > i0 + 31) dhi = i0 + 31;
            if (dhi > NB - 1) dhi = NB - 1;
#pragma unroll 1
            for (int D = dlo; D <= dhi; ++D) {
                const int bi = i0 + r - D; const bool valid = bi >= 0 && bi < NB; const int a = r & 7;
                const LAS bf16_t* fa = win + a * WP + (8 * h - 64 * mp - r - D * 128 - n0 + a);
                const LAS unsigned char* fb = lds + (valid ? bi * 272 : OFF_ZERO) + 16 * h;
                bf16x8 F[10], G[8];
#pragma unroll
                for (int k = 0; k < 10; ++k) F[k] = *(const LAS bf16x8*)(fa + 16 * (k - 2));
#pragma unroll
                for (int ks = 0; ks < 8; ++ks) G[ks] = *(const LAS bf16x8*)(fb + 32 * ks);
#pragma unroll
                for (int ks = 0; ks < 8; ++ks) { acc[0][0] = MFMA32(F[ks + 2], G[ks], acc[0][0]); acc[0][1] = MFMA32(F[ks], G[ks], acc[0][1]); }
            }
        }
        if (ci + 1 < NCHUNK) { LAS bf16_t* wb = (LAS bf16_t*)(lds + OFF_WIN_ + ((ci + 1) & 1) * WINB);
#pragma unroll
            for (int q = 0; q < NLD; ++q) { const int e = tid + NT * q;
                if (e < W + 7) {
#pragma unroll
                    for (int a = 0; a < 8; ++a) { const int m = e + a - 7; if (m >= 0 && m < W) wb[a * WP + m] = pre[q]; } } } }
        __syncthreads();
    }
    LAS bf16_t* hs = (LAS bf16_t*)(lds + OFF_WIN_);
    static_assert((L + 16) * 2 <= 2 * WINB && L % 8 == 0 && HOFF % 8 == 0, "filter half fits the window buffers; 16-byte staging");
    for (int e = tid; e < (L + 16) / 8; e += NT) *(LAS u32x4*)(hs + 8 * e) = *(const u32x4*)(HRc + HOFF - L + 8 * e);
    __syncthreads();
    {
        LAS float* tl = (LAS float*)(lds + OFF_TILE) + wid * (32 * 33);
#pragma unroll
        for (int s = 0; s < NSEQ; ++s)
#pragma unroll
            for (int mi = 0; mi < 2; ++mi) {
                WAVE_SYNC();
#pragma unroll
                for (int i = 0; i < 16; ++i) tl[r * 33 + crow32(i, h)] = acc[s][mi][i];
                WAVE_SYNC();
                if (i0 < NB) {
                    const int mt = 2 * mp + mi; const bf16_t* x0p = X0T + ((size_t)s * 512 + c) * LP; bf16_t* op = obuf + (size_t)s * LP * DM + 512 + c;
#pragma unroll 1
                    for (int it = 0; it < 16; ++it) { const int e = lane + 64 * it, j = e & 31, b = e >> 5, blk = i0 + b;
                        if (blk < NB) { const int jj = 32 * mt + j, t = 16 + blk * 128 + jj; float y = tl[b * 33 + j]; const LAS bf16_t* hp = hs + (L - t);
#pragma unroll
                            for (int sm = 0; sm < 16; ++sm) y += bf2f(hp[sm]) * um[s * 16 + sm];
                            y += dsk * bf2f(*(const LAS bf16_t*)(lds + s * SER_B + blk * 272 + jj * 2));
                            op[(size_t)t * DM] = (bf16_t)f2bf(bf2f(x0p[t]) * y); } }
                }
            }
    }
    __syncthreads();
    for (int e = tid; e < (L + 16) / 8; e += NT) *(LAS u32x4*)(hs + 8 * e) = *(const u32x4*)(HRc + HOFF - 16 + 8 * e);
    __syncthreads();
    for (int s = 0; s < NSEQ; ++s) {
        float ya[16];
#pragma unroll
        for (int t = 0; t < 16; ++t) ya[t] = 0.f;
        for (int sp = tid; sp < L; sp += NT) { const float uv = sp < 16 ? um[s * 16 + sp] : bf2f(*(const LAS bf16_t*)(lds + s * SER_B + ((sp - 16) >> 7) * 272 + ((sp - 16) & 127) * 2));
            const LAS bf16_t* hp = hs + sp + 16;
#pragma unroll
            for (int t = 0; t < 16; ++t) ya[t] += bf2f(hp[-t]) * uv; }
#pragma unroll
        for (int t = 0; t < 16; ++t) { const float v = wave_sum(ya[t]); if (lane == 0) red[(s * 8 + wid) * 16 + t] = v; }
    }
    __syncthreads();
    if (tid < 16 * NSEQ) { const int s = tid >> 4, t = tid & 15; float y = 0.f; for (int w = 0; w < 8; ++w) y += red[(s * 8 + w) * 16 + t];
        y += dsk * um[s * 16 + t]; const float x0 = bf2f(X0T[((size_t)s * 512 + c) * LP + t]);
        obuf[((size_t)s * LP + t) * DM + 512 + c] = (bf16_t)f2bf(x0 * y); }
    __syncthreads();
}
__device__ __forceinline__ int ppos(int x) { const int w = x & 31; return (x & ~31) + 8 * ((w >> 2) & 3) + 4 * ((w >> 4) & 1) + (w & 3); }
__device__ __forceinline__ void hgrn2_prep_unit(const Params& p, int l, int unit, LAS unsigned char* lds) {
    const bf16_t* proj = (const bf16_t*)(p.ws + OFF_PROJ);
    int tid_ = otid(); const int tid = tid_, hd = unit & 3, n = unit >> 2, t0 = n * 64;
    LAS float* qs = (LAS float*)lds; LAS float* ks = qs + 64 * 129; LAS float* bs = ks + 64 * 129; LAS bf16_t* vs = (LAS bf16_t*)(bs + 64 * 129); LAS bf16_t* qh = vs + 128 * 72; LAS bf16_t* kh = qh + 16 * 136; LAS float* lbs = (LAS float*)(kh + 64 * 136);
    for (int dir = 0; dir < 2; ++dir) {
        unsigned char* img = p.ws + OFF_HGOPS + ((size_t)(n * 4 + hd) * 2 + dir) * HG_UNIT;
        if (tid < 128) { const float* lbp = p.in[I_HGLB] + dir * 512 + hd * 128 + tid; float se = 0.f, sl = 0.f;
            for (int q = 0; q < DEPTH; ++q) { const float e = __expf(lbp[q * 1024]); se += e; if (q >= 1 && q <= l) sl += e; }
            lbs[tid] = sl / se; }
        __syncthreads();
        { const int tl = tid >> 3, d16 = (tid & 7) * 16, t = t0 + tl, i = dir ? 63 - tl : tl;
          const bf16_t* row = proj + (size_t)t * PP + hd * 128 + d16;
#pragma unroll
          for (int hf = 0; hf < 2; ++hf) {
              u32x4 qv = {0u, 0u, 0u, 0u}, fv = qv, vv = qv;
              if (t < L) { qv = *(const u32x4*)(row + CC_Q + 8 * hf); fv = *(const u32x4*)(row + (dir ? CC_FB : CC_FF) + 8 * hf); vv = *(const u32x4*)(row + CC_I + 8 * hf); }
#pragma unroll
              for (int j = 0; j < 8; ++j) { const int d = d16 + 8 * hf + j; const unsigned sh = (j & 1) ? 0xffff0000u : 0u;
                  const float qx = (j & 1) ? __uint_as_float(qv[j >> 1] & 0xffff0000u) : __uint_as_float(qv[j >> 1] << 16);
                  const float fx = (j & 1) ? __uint_as_float(fv[j >> 1] & 0xffff0000u) : __uint_as_float(fv[j >> 1] << 16);
                  (void)sh; float g = 0.f, kk = 0.f, qq = 0.f;
                  if (t < L) {
                      const float lb = lbs[d], sg = sigmoidf_(fx), fg = lb + (1.f - lb) * sg;
                      g = __logf(fg); kk = (1.f - lb) * (1.f - sg); qq = siluf_(qx) * 0.08838834764831845f; }
                  qs[i * 129 + d] = qq; ks[i * 129 + d] = kk; bs[i * 129 + d] = g;
                  vs[d * 72 + i] = (bf16_t)((j & 1) ? (vv[j >> 1] >> 16) : (vv[j >> 1] & 0xffffu)); } } }
        __syncthreads();
        if (tid < 128) { float gv[64];
#pragma unroll
            for (int i = 0; i < 64; ++i) gv[i] = bs[i * 129 + tid];
#pragma unroll
            for (int i = 1; i < 64; ++i) gv[i] += gv[i - 1];
#pragma unroll
            for (int i = 0; i < 64; ++i) bs[i * 129 + tid] = gv[i]; }
        __syncthreads();
        { const int i = tid >> 3, d16 = (tid & 7) * 16; bf16_t* qrow = (bf16_t*)(img + HG_QT) + i * 136;
#pragma unroll
          for (int q4 = 0; q4 < 4; ++q4) { float v[4];
#pragma unroll
              for (int lo = 0; lo < 4; ++lo) { const int d = d16 + 4 * q4 + lo; v[lo] = qs[i * 129 + d] * __expf(bs[i * 129 + d]); }
              u32x2 w; w.x = pk2(v[0], v[1]); w.y = pk2(v[2], v[3]); *(u32x2*)(qrow + ppos(d16 + 4 * q4)) = w; } }
        { const int d = tid >> 2, j16 = (tid & 3) * 16; const float bl = bs[63 * 129 + d]; float v[16];
#pragma unroll
          for (int j = 0; j < 16; ++j) v[j] = ks[(j16 + j) * 129 + d] * __expf(bl - bs[(j16 + j) * 129 + d]);
          u32x4 w0, w1; w0.x = pk2(v[0], v[1]); w0.y = pk2(v[2], v[3]); w0.z = pk2(v[4], v[5]); w0.w = pk2(v[6], v[7]); w1.x = pk2(v[8], v[9]); w1.y = pk2(v[10], v[11]); w1.z = pk2(v[12], v[13]); w1.w = pk2(v[14], v[15]);
          bf16_t* krow = (bf16_t*)(img + HG_KT) + d * 72 + j16; *(u32x4*)krow = w0; *(u32x4*)(krow + 8) = w1;
          bf16_t* vrow = (bf16_t*)(img + HG_VT) + d * 72 + j16; *(u32x4*)vrow = *(const LAS u32x4*)(vs + d * 72 + j16); *(u32x4*)(vrow + 8) = *(const LAS u32x4*)(vs + d * 72 + j16 + 8);
          if (tid < 128) ((float*)(img + HG_D))[tid] = __expf(bs[63 * 129 + tid]); }
#pragma unroll 1
        for (int I = 0; I < 4; ++I) {
            __syncthreads();
            for (int e = tid; e < (16 + 16 * (I + 1)) * 128; e += NT) { const int row = e >> 7, d = e & 127; const float ref = I ? bs[(16 * I - 1) * 129 + d] : 0.f;
                if (row < 16) { const int i = 16 * I + row; qh[row * 136 + d] = (bf16_t)f2bf(qs[i * 129 + d] * __expf(bs[i * 129 + d] - ref)); }
                else { const int j = row - 16; kh[j * 136 + d] = (bf16_t)f2bf(ks[j * 129 + d] * __expf(fminf(ref - bs[j * 129 + d], 60.f))); } }
            __syncthreads();
            const int wid = tid >> 6, lane = tid & 63, r16 = lane & 15, q4 = lane >> 4;
            if (wid < 4) { f32x4 acc = {0.f, 0.f, 0.f, 0.f};
                if (wid <= I) {
#pragma unroll
                    for (int ks_ = 0; ks_ < 4; ++ks_) { const bf16x8 af = *(const LAS bf16x8*)(qh + r16 * 136 + 32 * ks_ + 8 * q4), bfr = *(const LAS bf16x8*)(kh + (16 * wid + r16) * 136 + 32 * ks_ + 8 * q4);
                        acc = MFMA16(af, bfr, acc); } }
                bf16_t* arow = (bf16_t*)(img + HG_A) + (16 * I + 4 * q4) * 72 + 16 * wid + r16;
#pragma unroll
                for (int j4 = 0; j4 < 4; ++j4) { const int i = 16 * I + 4 * q4 + j4, j = 16 * wid + r16; arow[j4 * 72] = (bf16_t)f2bf(j <= i ? acc[j4] : 0.f); } }
        }
        __syncthreads();
    }
}
__device__ __forceinline__ void gdn_prep_unit(const Params& p, int l, int unit, LAS unsigned char* lds) {
    const bf16_t* proj = (const bf16_t*)(p.ws + OFF_PROJ);
    int tid_ = otid(); const int tid = tid_, hd = unit & 3, n = unit >> 2, t0 = n * 64;
    LAS float* qs = (LAS float*)lds; LAS float* ks = qs + 64 * 131; LAS float* vs = ks + 64 * 131;
    LAS float* kk = vs + 64 * 131; LAS float* mtb = kk + 64 * 68; LAS float* qk = mtb + 64 * 68; LAS float* beta = qk + 64 * 68; LAS float* gg = beta + 128; LAS float* bc = gg + 128; LAS float* rf = bc + 128;
    const float* cwg = p.in[I_GCW] + (size_t)l * 3 * 1536; LAS float* cw = rf + 256;
    for (int e = tid; e < 3 * 384; e += NT) { const int dl = e / 384, c = e - dl * 384; cw[e] = cwg[(size_t)dl * 1536 + (c >> 7) * 512 + hd * 128 + (c & 127)]; }
    __syncthreads();
    { const int tl = tid >> 3, d16 = (tid & 7) * 16, t = t0 + tl; float q[16], k[16], v[16];
#pragma unroll
      for (int j = 0; j < 16; ++j) { q[j] = 0.f; k[j] = 0.f; v[j] = 0.f; }
      if (t < L) {
          u32x4 ra[3][2], rb[3][2], rc[3][2];
#pragma unroll
          for (int dlt = 0; dlt < 3; ++dlt) { const int tt = t + dlt - 1; const bool in = tt >= 0 && tt < L; const bf16_t* row = proj + (size_t)(in ? tt : t) * PP + CD_Q + hd * 128 + d16;
#pragma unroll
              for (int hf = 0; hf < 2; ++hf) { ra[dlt][hf] = *(const u32x4*)(row + 8 * hf); rb[dlt][hf] = *(const u32x4*)(row + 512 + 8 * hf); rc[dlt][hf] = *(const u32x4*)(row + 1024 + 8 * hf);
                  if (!in) { ra[dlt][hf] = (u32x4){0u, 0u, 0u, 0u}; rb[dlt][hf] = ra[dlt][hf]; rc[dlt][hf] = ra[dlt][hf]; } } }
#pragma unroll
          for (int dlt = 0; dlt < 3; ++dlt) { const LAS float* w = cw + dlt * 384 + d16;
#pragma unroll
              for (int hf = 0; hf < 2; ++hf) { const u32x4 a = ra[dlt][hf], b = rb[dlt][hf], c = rc[dlt][hf];
#pragma unroll
                  for (int j = 0; j < 4; ++j) { const int e = 8 * hf + 2 * j;
                      q[e] += w[e] * __uint_as_float(a[j] << 16); q[e + 1] += w[e + 1] * __uint_as_float(a[j] & 0xffff0000u);
                      k[e] += w[128 + e] * __uint_as_float(b[j] << 16); k[e + 1] += w[128 + e + 1] * __uint_as_float(b[j] & 0xffff0000u);
                      v[e] += w[256 + e] * __uint_as_float(c[j] << 16); v[e + 1] += w[256 + e + 1] * __uint_as_float(c[j] & 0xffff0000u); } } }
      }
      float sq = 0.f, sk = 0.f;
#pragma unroll
      for (int j = 0; j < 16; ++j) { q[j] = siluf_(q[j]); k[j] = siluf_(k[j]); v[j] = siluf_(v[j]); sq += q[j] * q[j]; sk += k[j] * k[j]; }
      sq += __shfl_xor(sq, 1); sq += __shfl_xor(sq, 2); sq += __shfl_xor(sq, 4); sk += __shfl_xor(sk, 1); sk += __shfl_xor(sk, 2); sk += __shfl_xor(sk, 4);
      const float rq = 1.f / sqrtf(sq + 1e-6f) * 0.08838834764831845f, rk = 1.f / sqrtf(sk + 1e-6f);
#pragma unroll
      for (int j = 0; j < 16; ++j) { qs[tl * 131 + d16 + j] = q[j] * rq; ks[tl * 131 + d16 + j] = k[j] * rk; vs[tl * 131 + d16 + j] = v[j]; } }
    if (tid < 128) { const int dir = tid >> 6, tl = tid & 63, t = t0 + tl; float be = 0.f, g = 0.f;
        if (t < L) { const bf16_t* row = proj + (size_t)t * PP; be = sigmoidf_(bf2f(row[(dir ? CD_BB : CD_BF) + hd]));
            const float x = bf2f(row[(dir ? CD_AB : CD_AF) + hd]) + p.in[I_GDT][(l * 2 + dir) * 4 + hd]; const float sp = x > 20.f ? x : log1pf(__expf(x));
            g = -__expf(p.in[I_GALOG][(l * 2 + dir) * 4 + hd]) * sp; }
        beta[dir * 64 + tl] = be; gg[dir * 64 + tl] = g; }
    __syncthreads();
    { int t2 = tid; OPAQUE(t2); const int i = t2 >> 3, j8 = (t2 & 7) * 8; float a[8], b[8];
#pragma unroll
      for (int j = 0; j < 8; ++j) { a[j] = 0.f; b[j] = 0.f; }
#pragma unroll 2
      for (int d = 0; d < 128; ++d) { const float ki = ks[i * 131 + d], qi = qs[i * 131 + d];
#pragma unroll
          for (int j = 0; j < 8; ++j) { const float kj = ks[(j8 + j) * 131 + d]; a[j] += ki * kj; b[j] += qi * kj; } }
#pragma unroll
      for (int j = 0; j < 8; ++j) { kk[i * 68 + j8 + j] = a[j]; qk[i * 68 + j8 + j] = b[j]; } }
    if (tid < 128) { const int d_ = tid >> 6, i = tid & 63; float a = gg[d_ * 64 + (d_ ? 63 - i : i)];
#pragma unroll
        for (int o = 1; o < 64; o <<= 1) { const float nb = __shfl_up(a, o); if (i >= o) a += nb; }
        bc[d_ * 64 + i] = a; }
    __syncthreads();
    if (tid < 256) { const int d_ = tid >> 7, ty = (tid >> 6) & 1, i = tid & 63, tl = d_ ? 63 - i : i; rf[(d_ * 2 + ty) * 64 + i] = beta[d_ * 64 + tl] * (ty ? __expf(bc[d_ * 64 + i]) : 1.f); }
    int t4 = tid; OPAQUE(t4); const int dir = t4 >> 8;
    unsigned char* img = p.ws + OFF_GDOPS + ((size_t)(n * 4 + hd) * 2 + dir) * GD_UNIT;
    { const int ht = t4 & 255; const float bl = bc[dir * 64 + 63];
      for (int e = ht; e < 64 * 32; e += 256) { const int i = e >> 5, d4 = (e & 31) * 4, tl = dir ? 63 - i : i; const float eb = __expf(bc[dir * 64 + i]);
          u32x2 w; w.x = pk2(qs[tl * 131 + d4] * eb, qs[tl * 131 + d4 + 1] * eb); w.y = pk2(qs[tl * 131 + d4 + 2] * eb, qs[tl * 131 + d4 + 3] * eb);
          *(u32x2*)((bf16_t*)(img + GD_QE) + i * 136 + ppos(d4)) = w; }
      for (int e = ht; e < 128 * 16; e += 256) { const int d = e >> 4, j4 = (e & 15) * 4; float v[4];
#pragma unroll
          for (int q = 0; q < 4; ++q) { const int j = j4 + q, tl = dir ? 63 - j : j; v[q] = ks[tl * 131 + d] * __expf(bl - bc[dir * 64 + j]); }
          u32x2 w; w.x = pk2(v[0], v[1]); w.y = pk2(v[2], v[3]); *(u32x2*)((bf16_t*)(img + GD_KDT) + d * 72 + ppos(j4)) = w; }
      for (int e = ht; e < 64 * 16; e += 256) { const int i = e >> 4, j4 = (e & 15) * 4, ti = dir ? 63 - i : i; float v[4];
#pragma unroll
          for (int q = 0; q < 4; ++q) { const int j = j4 + q, tj = dir ? 63 - j : j; v[q] = j <= i ? qk[ti * 68 + tj] * __expf(bc[dir * 64 + i] - bc[dir * 64 + j]) : 0.f; }
          u32x2 w; w.x = pk2(v[0], v[1]); w.y = pk2(v[2], v[3]); *(u32x2*)((bf16_t*)(img + GD_QK) + i * 72 + ppos(j4)) = w; }
      if (ht == 0) *(float*)(img + GD_BL) = __expf(bl); }
    __syncthreads();
    for (int e = tid; e < 4096; e += NT) { const int i = e >> 6, j = e & 63;
        mtb[i * 68 + j] = i > j ? beta[64 + 63 - i] * kk[(63 - i) * 68 + (63 - j)] * __expf(bc[64 + i] - bc[64 + j]) : 0.f; }
    __syncthreads();
    for (int e = tid; e < 4096; e += NT) { const int i = e >> 6, j = e & 63;
        kk[i * 68 + j] = i > j ? beta[i] * kk[i * 68 + j] * __expf(bc[i] - bc[j]) : 0.f; }
    __syncthreads();
    LAS float* TT0 = qk; LAS float* TT1 = qs;
    { const int d_ = tid >> 8, jc = (tid >> 2) & 63, part = tid & 3; const LAS float* M = d_ ? mtb : kk; LAS float* T = (d_ ? TT1 : TT0) + jc * 68;
        for (int i = 4 * part; i < 64; i += 16) *(LAS f32x4*)(T + i) = (f32x4){i == jc ? 1.f : 0.f, i + 1 == jc ? 1.f : 0.f, i + 2 == jc ? 1.f : 0.f, i + 3 == jc ? 1.f : 0.f};
        WAVE_SYNC();
#pragma unroll 1
        for (int i = 1; i < 64; ++i) { f32x4 s0 = {0.f, 0.f, 0.f, 0.f}; const LAS float* Mi = M + i * 68;
            if (i > jc) { for (int j = (jc & ~3) + 4 * part; j < i; j += 16) { const f32x4 m0 = *(const LAS f32x4*)(Mi + j), t0 = *(const LAS f32x4*)(T + j); s0 += m0 * t0; } }
            float s = (s0[0] + s0[1]) + (s0[2] + s0[3]); s += __shfl_xor(s, 1); s += __shfl_xor(s, 2);
            if (i > jc && part == 0) T[i] = -s;
            WAVE_SYNC(); } }
    __syncthreads();
    { int t3 = tid; OPAQUE(t3); const int dir = t3 >> 8, c = t3 & 255;
      unsigned char* img = p.ws + OFF_GDOPS + ((size_t)(n * 4 + hd) * 2 + dir) * GD_UNIT;
      const LAS float* src = (c < 128 ? vs + c : ks + (c - 128)) + (dir ? 63 * 131 : 0); const int step = dir ? -131 : 131;
      const LAS float* fac = rf + (dir * 2 + (c < 128 ? 0 : 1)) * 64; const LAS float* TT = dir ? TT1 : TT0;
      float x[64];
#pragma unroll
      for (int i = 0; i < 64; ++i) x[i] = 0.f;
#pragma unroll 2
      for (int j = 0; j < 64; ++j) { const float rj = fac[j] * src[j * step]; const LAS float* row = TT + j * 68;
#pragma unroll
          for (int i4 = 0; i4 < 16; ++i4) { const f32x4 m = *(const LAS f32x4*)(row + 4 * i4);
              x[4 * i4] += m[0] * rj; x[4 * i4 + 1] += m[1] * rj; x[4 * i4 + 2] += m[2] * rj; x[4 * i4 + 3] += m[3] * rj; } }
      if (c < 128) { bf16_t* urow = (bf16_t*)(img + GD_UT) + c * 72;
#pragma unroll
          for (int g8 = 0; g8 < 8; ++g8) { u32x4 w; w.x = pk2(x[8 * g8], x[8 * g8 + 1]); w.y = pk2(x[8 * g8 + 2], x[8 * g8 + 3]); w.z = pk2(x[8 * g8 + 4], x[8 * g8 + 5]); w.w = pk2(x[8 * g8 + 6], x[8 * g8 + 7]); *(u32x4*)(urow + 8 * g8) = w; }
      } else { bf16_t* wcol = (bf16_t*)(img + GD_W) + ppos(c - 128);
#pragma unroll
          for (int i = 0; i < 64; ++i) wcol[i * 136] = (bf16_t)f2bf(x[i]); } }
    __syncthreads();
}
__device__ __forceinline__ bf16x8 pack_tiles(const f32x4& a, const f32x4& b) { u32x4 w; w.x = pk2(a[0], a[1]); w.y = pk2(a[2], a[3]); w.z = pk2(b[0], b[1]); w.w = pk2(b[2], b[3]); return __builtin_bit_cast(bf16x8, w); }
template <bool GDN> __device__ __forceinline__ void scan_stream(const Params& p, int sid, LAS unsigned char* lds) {
    constexpr int UB = GDN ? GD_UNIT : HG_UNIT, NPC = UB / 16, NIT = (NPC + NT - 1) / NT;
    static_assert(UB % 16 == 0 && 2 * UB <= 160 * 1024, "scan image");
    int tid_ = otid(); const int hd = sid & 3, dir = sid >> 2, tid = tid_, wid = tid >> 6, lane = tid & 63, r16 = lane & 15, q4 = lane >> 4, dv0 = 16 * wid;
    const unsigned char* ops = p.ws + (GDN ? OFF_GDOPS : OFF_HGOPS) + ((size_t)hd * 2 + dir) * UB;
    float* osc = (float*)(p.ws + OFF_OSC) + (size_t)((GDN ? 2 : 0) + dir) * LP * 512;
    f32x4 S[8];
#pragma unroll
    for (int c = 0; c < 8; ++c) S[c] = (f32x4){0.f, 0.f, 0.f, 0.f};
    { const unsigned char* src = ops + (size_t)(dir ? NCH - 1 : 0) * 8 * UB;
#pragma unroll
      for (int it = 0; it < NIT; ++it) { const int pc = tid + NT * it; if (pc < NPC) *(LAS u32x4*)(lds + pc * 16) = *(const u32x4*)(src + pc * 16); } }
    __syncthreads();
    for (int k = 0; k < NCH; ++k) {
        const int n = dir ? NCH - 1 - k : k; LAS unsigned char* B = lds + (k & 1) * UB;
        if (k + 1 < NCH) { const unsigned char* src = ops + (size_t)(dir ? n - 1 : n + 1) * 8 * UB; LAS unsigned char* Bn = lds + ((k + 1) & 1) * UB;
#pragma unroll
            for (int it = 0; it < NIT; ++it) { const int pc = tid + NT * it; if (pc < NPC) __builtin_amdgcn_global_load_lds((const unsigned*)(src + pc * 16), (LAS unsigned*)(Bn + (pc - lane) * 16), 16, 0, 0); } }
        bf16x8 bS[4], bV[2];
#pragma unroll
        for (int ks = 0; ks < 4; ++ks) bS[ks] = pack_tiles(S[2 * ks], S[2 * ks + 1]);
        f32x4 O[4];
#pragma unroll
        for (int mt = 0; mt < 4; ++mt) O[mt] = (f32x4){0.f, 0.f, 0.f, 0.f};
        bf16x8 fa[16], fb[8];
        if constexpr (GDN) {
            f32x4 T[4]; u32x2 uu[4];
#pragma unroll
            for (int mt = 0; mt < 4; ++mt) T[mt] = (f32x4){0.f, 0.f, 0.f, 0.f};
#pragma unroll
            for (int ks = 0; ks < 4; ++ks)
#pragma unroll
                for (int mt = 0; mt < 4; ++mt) fa[4 * ks + mt] = *(const LAS bf16x8*)(B + GD_W + ((16 * mt + r16) * 136 + 32 * ks + 8 * q4) * 2);
#pragma unroll
            for (int mt = 0; mt < 4; ++mt) uu[mt] = *(const LAS u32x2*)(B + GD_UT + ((dv0 + r16) * 72 + 16 * mt + 4 * q4) * 2);
            __builtin_amdgcn_sched_barrier(0);
#pragma unroll
            for (int ks = 0; ks < 4; ++ks)
#pragma unroll
                for (int mt = 0; mt < 4; ++mt) T[mt] = MFMA16(fa[4 * ks + mt], bS[ks], T[mt]);
            __builtin_amdgcn_sched_barrier(0);
#pragma unroll
            for (int ks = 0; ks < 4; ++ks)
#pragma unroll
                for (int mt = 0; mt < 4; ++mt) fa[4 * ks + mt] = *(const LAS bf16x8*)(B + GD_QE + ((16 * mt + r16) * 136 + 32 * ks + 8 * q4) * 2);
            __builtin_amdgcn_sched_barrier(0);
#pragma unroll
            for (int ks = 0; ks < 4; ++ks)
#pragma unroll
                for (int mt = 0; mt < 4; ++mt) O[mt] = MFMA16(fa[4 * ks + mt], bS[ks], O[mt]);
            __builtin_amdgcn_sched_barrier(0);
#pragma unroll
            for (int ks = 0; ks < 2; ++ks)
#pragma unroll
                for (int mt = 0; mt < 4; ++mt) fa[4 * ks + mt] = *(const LAS bf16x8*)(B + GD_QK + ((16 * mt + r16) * 72 + 32 * ks + 8 * q4) * 2);
#pragma unroll
            for (int c = 0; c < 4; ++c)
#pragma unroll
                for (int ks = 0; ks < 2; ++ks) fb[2 * c + ks] = *(const LAS bf16x8*)(B + GD_KDT + ((16 * c + r16) * 72 + 32 * ks + 8 * q4) * 2);
            const float bl = *(const LAS float*)(B + GD_BL);
#pragma unroll
            for (int mt = 0; mt < 4; ++mt) { T[mt][0] = __uint_as_float(uu[mt].x << 16) - T[mt][0]; T[mt][1] = __uint_as_float(uu[mt].x & 0xffff0000u) - T[mt][1];
                T[mt][2] = __uint_as_float(uu[mt].y << 16) - T[mt][2]; T[mt][3] = __uint_as_float(uu[mt].y & 0xffff0000u) - T[mt][3]; }
            bV[0] = pack_tiles(T[0], T[1]); bV[1] = pack_tiles(T[2], T[3]);
#pragma unroll
            for (int c = 0; c < 8; ++c) S[c] = S[c] * bl;
            __builtin_amdgcn_sched_barrier(0);
#pragma unroll
            for (int ks = 0; ks < 2; ++ks)
#pragma unroll
                for (int mt = 0; mt < 4; ++mt) O[mt] = MFMA16(fa[4 * ks + mt], bV[ks], O[mt]);
#pragma unroll
            for (int c = 0; c < 4; ++c)
#pragma unroll
                for (int ks = 0; ks < 2; ++ks) S[c] = MFMA16(fb[2 * c + ks], bV[ks], S[c]);
            __builtin_amdgcn_sched_barrier(0);
#pragma unroll
            for (int c = 0; c < 4; ++c)
#pragma unroll
                for (int ks = 0; ks < 2; ++ks) fb[2 * c + ks] = *(const LAS bf16x8*)(B + GD_KDT + ((16 * (c + 4) + r16) * 72 + 32 * ks + 8 * q4) * 2);
            __builtin_amdgcn_sched_barrier(0);
#pragma unroll
            for (int c = 0; c < 4; ++c)
#pragma unroll
                for (int ks = 0; ks < 2; ++ks) S[c + 4] = MFMA16(fb[2 * c + ks], bV[ks], S[c + 4]);
        } else {
#pragma unroll
            for (int ks = 0; ks < 4; ++ks)
#pragma unroll
                for (int mt = 0; mt < 4; ++mt) fa[4 * ks + mt] = *(const LAS bf16x8*)(B + HG_QT + ((16 * mt + r16) * 136 + 32 * ks + 8 * q4) * 2);
#pragma unroll
            for (int ks = 0; ks < 2; ++ks) bV[ks] = *(const LAS bf16x8*)(B + HG_VT + ((dv0 + r16) * 72 + 32 * ks + 8 * q4) * 2);
#pragma unroll
            for (int ks = 0; ks < 2; ++ks)
#pragma unroll
                for (int mt = 0; mt < 4; ++mt) fb[4 * ks + mt] = *(const LAS bf16x8*)(B + HG_A + ((16 * mt + r16) * 72 + 32 * ks + 8 * q4) * 2);
            __builtin_amdgcn_sched_barrier(0);
#pragma unroll
            for (int ks = 0; ks < 4; ++ks)
#pragma unroll
                for (int mt = 0; mt < 4; ++mt) O[mt] = MFMA16(fa[4 * ks + mt], bS[ks], O[mt]);
#pragma unroll
            for (int ks = 0; ks < 2; ++ks)
#pragma unroll
                for (int mt = 0; mt < 4; ++mt) O[mt] = MFMA16(fb[4 * ks + mt], bV[ks], O[mt]);
            __builtin_amdgcn_sched_barrier(0);
#pragma unroll
            for (int c = 0; c < 8; ++c)
#pragma unroll
                for (int ks = 0; ks < 2; ++ks) fa[2 * c + ks] = *(const LAS bf16x8*)(B + HG_KT + ((16 * c + r16) * 72 + 32 * ks + 8 * q4) * 2);
#pragma unroll
            for (int c = 0; c < 8; ++c) { const f32x4 d4 = *(const LAS f32x4*)(B + HG_D + (16 * c + 4 * q4) * 4); S[c] = S[c] * d4; }
            __builtin_amdgcn_sched_barrier(0);
#pragma unroll
            for (int c = 0; c < 8; ++c)
#pragma unroll
                for (int ks = 0; ks < 2; ++ks) S[c] = MFMA16(fa[2 * c + ks], bV[ks], S[c]);
        }
        { float* ob = osc + (size_t)(64 * n) * 512 + hd * 128 + dv0 + r16;
#pragma unroll
          for (int mt = 0; mt < 4; ++mt)
#pragma unroll
              for (int j = 0; j < 4; ++j) { const int i = 16 * mt + 4 * q4 + j, tl = dir ? 63 - i : i; ob[tl * 512] = O[mt][j]; } }
        WAITCNT_VM(0);
        __syncthreads();
    }
}
__device__ __forceinline__ void stage_mixfin(const Params& p, int l, int seq) {
    const bf16_t* proj = (const bf16_t*)(p.ws + OFF_PROJ); bf16_t* obuf = (bf16_t*)(p.ws + OFF_OBUF) + (size_t)seq * LP * DM;
    const int lane = otid() & 63, gw = blockIdx.x * 8 + (otid() >> 6), NGW = gridDim.x * 8, e0 = lane * 8;
    const float lam_init = 0.8f - 0.6f * expf(-0.3f * (float)l);
    float lam; { const float a = p.in[I_LQ1][l * 64 + lane] * p.in[I_LK1][l * 64 + lane], b = p.in[I_LQ2][l * 64 + lane] * p.in[I_LK2][l * 64 + lane]; lam = expf(wave_sum(a)) - expf(wave_sum(b)) + lam_init; }
    float ng[3][8];
#pragma unroll
    for (int j = 0; j < 8; ++j) { ng[0][j] = p.in[I_HGNG][(size_t)l * 128 + (e0 & 127) + j]; ng[1][j] = p.in[I_GNG][(size_t)l * 128 + (e0 & 127) + j]; ng[2][j] = p.in[I_ANG][(size_t)l * 128 + (e0 & 127) + j] * (1.f - lam_init); }
    const float* osc = (const float*)(p.ws + OFF_OSC); const float* ao = (const float*)(p.ws + OFF_AO0);
    for (int t = gw; t < L; t += NGW) {
        f32x4 a[3][2], b[3][2]; u32x4 gv[2];
#pragma unroll
        for (int job = 0; job < 2; ++job) { const float* of = osc + (size_t)(2 * job) * LP * 512 + (size_t)t * 512 + e0; const float* ob = of + (size_t)LP * 512;
            a[job][0] = *(const f32x4*)of; a[job][1] = *(const f32x4*)(of + 4); b[job][0] = *(const f32x4*)ob; b[job][1] = *(const f32x4*)(ob + 4);
            gv[job] = *(const u32x4*)(proj + (size_t)t * PP + (job ? CD_Z : CC_G) + e0); }
        { const float* o0 = ao + (size_t)t * 512 + e0; const float* o1 = o0 + (size_t)LP * 512;
          a[2][0] = *(const f32x4*)o0; a[2][1] = *(const f32x4*)(o0 + 4); b[2][0] = *(const f32x4*)o1 * -lam; b[2][1] = *(const f32x4*)(o1 + 4) * -lam; }
#pragma unroll
        for (int job = 0; job < 3; ++job) { float o[8]; float ss = 0.f;
#pragma unroll
            for (int j = 0; j < 4; ++j) { o[j] = a[job][0][j] + b[job][0][j]; o[4 + j] = a[job][1][j] + b[job][1][j]; }
#pragma unroll
            for (int j = 0; j < 8; ++j) ss += o[j] * o[j];
            ss += __shfl_xor(ss, 1); ss += __shfl_xor(ss, 2); ss += __shfl_xor(ss, 4); ss += __shfl_xor(ss, 8);
            const float rinv = 1.f / sqrtf(ss * (1.f / 128.f) + RMS_EPS);
            u32x4 w;
            if (job < 2) {
#pragma unroll
                for (int j = 0; j < 4; ++j) { const float g0 = __uint_as_float(gv[job][j] << 16), g1 = __uint_as_float(gv[job][j] & 0xffff0000u);
                    w[j] = pk2(o[2 * j] * rinv * ng[job][2 * j] * siluf_(g0), o[2 * j + 1] * rinv * ng[job][2 * j + 1] * siluf_(g1)); }
                *(u32x4*)(obuf + (size_t)t * DM + 1024 + 512 * job + e0) = w;
            } else {
#pragma unroll
                for (int j = 0; j < 4; ++j) w[j] = pk2(o[2 * j] * rinv * ng[2][2 * j], o[2 * j + 1] * rinv * ng[2][2 * j + 1]);
                *(u32x4*)(obuf + (size_t)t * DM + e0) = w; } }
    }
}
__device__ __forceinline__ void stage_prep(const Params& p, int l, int seq, LAS unsigned char* lds, int qoff = 0) {
    constexpr int N_G = NCH * 4, N_H = NCH * 4, N_Y = (LP / 64) * 8, N_A = LP / 64, N_ALL = N_G + N_H + N_Y + N_A;
    unsigned* head = (unsigned*)(p.ws + OFF_CTL) + CW_QUEUE + 64 * (2 * DEPTH * NSEQ + l * NSEQ + seq + qoff);
    LAS int* slot = (LAS int*)(lds + LDS_BYTES - 32);
    for (;;) {
        __syncthreads();
        if (otid() == 0) *slot = (int)__hip_atomic_fetch_add(head, 1u, __ATOMIC_RELAXED, __HIP_MEMORY_SCOPE_AGENT);
        __syncthreads();
        const int u = *slot;
        if (u >= N_ALL) break;
        if (u < N_G) gdn_prep_unit(p, l, u, lds);
        else if (u < N_G + N_H) hgrn2_prep_unit(p, l, u - N_G, lds);
        else if (u < N_G + N_H + N_Y) hyena_prep_unit(p, l, seq, u - N_G - N_H, lds);
        else attn_prep_unit(p, u - N_G - N_H - N_Y, lds);
    }
}
__device__ __forceinline__ void stage_mix(const Params& p, int l, int seq, LAS unsigned char* lds, int qoff = 0, int mask = 7) {
    constexpr int NQB = (L + 255) / 256, N_ATT = 8 * NQB, N_ALL = 16 + N_ATT + 512;
    unsigned* head = (unsigned*)(p.ws + OFF_CTL) + CW_QUEUE + 64 * (l * NSEQ + seq + qoff);
    LAS int* slot = (LAS int*)(lds + LDS_BYTES - 32);
    for (;;) {
        __syncthreads();
        if (otid() == 0) *slot = (int)__hip_atomic_fetch_add(head, 1u, __ATOMIC_RELAXED, __HIP_MEMORY_SCOPE_AGENT);
        __syncthreads();
        const int u = *slot;
        if (u >= N_ALL) break;
        if (u < 8) { if (mask & 1) scan_stream<true>(p, u, lds); }
        else if (u < 16) { if (mask & 1) scan_stream<false>(p, u - 8, lds); }
        else if (u < 16 + N_ATT) { if (mask & 2) attn_unit(p, u - 16, lds); }
        else if (mask & 4) hyena_conv_unit(p, l, u - 16 - N_ATT, seq, lds);
    }
}
#define XB_TMO      128
#define XB_XCNT(j)  (256  + 64 * (j))
#define XB_XSUB(j)  (1280 + 64 * (j))
#define XB_XGEN(j)  (2304 + 64 * (j))
#define XB_TOP      3328
#define XB_TOPGEN   3392
#define XCD_BAR_WORDS 3456
#ifdef HIPEMU
#define XB_SPIN_CAP (1u << 30)
#else
#define XB_SPIN_CAP (1u << 22)
#endif

__device__ __forceinline__ unsigned xb_ld(unsigned* p)              { return __hip_atomic_load(p, __ATOMIC_RELAXED, __HIP_MEMORY_SCOPE_AGENT); }
__device__ __forceinline__ unsigned xb_add(unsigned* p, unsigned v) { return __hip_atomic_fetch_add(p, v, __ATOMIC_RELAXED, __HIP_MEMORY_SCOPE_AGENT); }
__device__ __forceinline__ unsigned xb_xcc_id() { return (unsigned)__builtin_amdgcn_s_getreg((3 << 11) | 20) & 0xFu; }
#define XB_SPIN(cond, bar) do { unsigned _sp = 0; while (cond) { __builtin_amdgcn_s_sleep(1); \
    if ((++_sp & 255u) == 0u) { if (xb_ld(&(bar)[XB_TMO])) break; if (_sp > XB_SPIN_CAP) { atomicAdd(&(bar)[XB_TMO], 1u); break; } } } } while (0)

struct XcdBarrier {
    unsigned* bar; unsigned x;
    volatile LAS unsigned* st;
};

__device__ __forceinline__ XcdBarrier xcd_barrier_post(unsigned* bar, volatile LAS unsigned* st) {
    XcdBarrier b; b.bar = bar; b.x = xb_xcc_id(); b.st = st;
    if (threadIdx.x == 0) (void)xb_add(&bar[XB_XCNT(b.x)], 1u);
    return b;
}
__device__ __forceinline__ void xcd_barrier_complete(unsigned* bar, unsigned x, unsigned& nloc, unsigned& nx) {
    const unsigned G = gridDim.x * gridDim.y * gridDim.z;
    unsigned sum, cnt, mine, sp = 0u;
    for (;;) {
        sum = 0u; cnt = 0u; mine = 0u;
#pragma unroll
        for (unsigned j = 0; j < 16; ++j) { const unsigned c = xb_ld(&bar[XB_XCNT(j)]); sum += c; cnt += (c > 0u) ? 1u : 0u; mine = (j == x) ? c : mine; }
        if (sum == G) break;
        __builtin_amdgcn_s_sleep(1);
        if ((++sp & 255u) == 0u) { if (xb_ld(&bar[XB_TMO])) break; if (sp > XB_SPIN_CAP) { atomicAdd(&bar[XB_TMO], 1u); break; } }
    }
    nloc = mine > 0u ? mine : 1u; nx = cnt > 0u ? cnt : 1u;
}

__device__ __forceinline__ void xcd_barrier(const XcdBarrier& b) {
    WAITCNT_VM(0);
    __syncthreads();
    if (threadIdx.x == 0) {
        unsigned* bar = b.bar;
        WAITCNT_ALL();
        unsigned nloc = b.st[0], nx = b.st[1];
        if (nloc == 0u) { xcd_barrier_complete(bar, b.x, nloc, nx); b.st[0] = nloc; b.st[1] = nx; }
        const unsigned old = xb_add(&bar[XB_XSUB(b.x)], 1u);
        const unsigned gen = old / nloc;
        if (old + 1u == (gen + 1u) * nloc) {
            FENCE_RELEASE_AGENT();
            WAITCNT_VM(0);
            const unsigned og = xb_add(&bar[XB_TOP], 1u);
            const unsigned tg = og / nx;
            if (og + 1u == (tg + 1u) * nx) xb_add(&bar[XB_TOPGEN], 1u);
            else XB_SPIN(xb_ld(&bar[XB_TOPGEN]) == tg, bar);
            FENCE_ACQUIRE_AGENT();
            xb_add(&bar[XB_XGEN(b.x)], 1u);
            WAITCNT_VM(0);
        } else {
            XB_SPIN(xb_ld(&bar[XB_XGEN(b.x)]) == gen, bar);
            FENCE_ACQUIRE_AGENT();
            WAITCNT_VM(0);
        }
    }
    __syncthreads();
}

enum { ST_ROPE = 0, ST_EMBED, ST_CONVERT, ST_HYF_RAW, ST_HYF_FIN, ST_GEMM_IN, ST_PREP, ST_MIX, ST_MIXFIN, ST_GEMM_OUT, ST_LN1, ST_GEMM_UP, ST_FFNCONV, ST_GEMM_DOWN, ST_LN2, N_STAGES };

template <int ST> __device__ __forceinline__ void run_stage(const Params& p, int l, int seq, LAS unsigned char* lds) {
    if constexpr (ST == ST_ROPE) stage_rope(p);
    else if constexpr (ST == ST_EMBED) stage_embed(p);
    else if constexpr (ST == ST_CONVERT) stage_convert_weights(p, l, lds);
    else if constexpr (ST == ST_HYF_RAW) stage_hyena_filter_raw(p, l, lds);
    else if constexpr (ST == ST_HYF_FIN) stage_hyena_filter_fin(p, l, lds);
    else if constexpr (ST == ST_GEMM_IN) { EpiStoreBf16 E; E.O = (bf16_t*)(p.ws + OFF_PROJ); E.ldc = PP;
        stage_gemm(lds, (const bf16_t*)(p.ws + OFF_HBF) + (size_t)seq * LP * DM, (const bf16_t*)(p.ws + OFF_WIN), SEQ, PP, DM, E);
        tail_gemm<false>(p, (const bf16_t*)(p.ws + OFF_HBF) + ((size_t)seq * LP + SEQ) * DM, (const bf16_t*)(p.ws + OFF_WIN), PP, DM, E.O + (size_t)SEQ * PP, PP, seq, lds); }
    else if constexpr (ST == ST_PREP) stage_prep(p, l, seq, lds);
    else if constexpr (ST == ST_MIX) stage_mix(p, l, seq, lds);
    else if constexpr (ST == ST_MIXFIN) stage_mixfin(p, l, seq);
    else if constexpr (ST == ST_GEMM_OUT) {
        const float* lg = l ? p.in[I_LN2G] + (size_t)(l - 1) * DM : nullptr; const float* lb = l ? p.in[I_LN2B] + (size_t)(l - 1) * DM : nullptr;
        for (int s = 0; s < NSEQ; ++s) { EpiResid E; E.p = p; E.row_base = s * LP; E.ln_g = lg; E.ln_b = lb;
            stage_gemm(lds, (const bf16_t*)(p.ws + OFF_OBUF) + (size_t)s * LP * DM, (const bf16_t*)(p.ws + OFF_WOUT), SEQ, DM, DM, E);
            tail_gemm<true>(p, (const bf16_t*)(p.ws + OFF_OBUF) + ((size_t)s * LP + SEQ) * DM, (const bf16_t*)(p.ws + OFF_WOUT), DM, DM, nullptr, 0, s, lds, lg, lb); } }
    else if constexpr (ST == ST_LN1) stage_ln(p, l, 0);
    else if constexpr (ST == ST_GEMM_UP) { EpiStoreBf16 E; E.O = (bf16_t*)(p.ws + OFF_U); E.ldc = 2 * DFF;
        stage_gemm(lds, (const bf16_t*)(p.ws + OFF_HBF) + (size_t)seq * LP * DM, (const bf16_t*)(p.ws + OFF_WUP), SEQ, 2 * DFF, DM, E);
        tail_gemm<false>(p, (const bf16_t*)(p.ws + OFF_HBF) + ((size_t)seq * LP + SEQ) * DM, (const bf16_t*)(p.ws + OFF_WUP), 2 * DFF, DM, E.O + (size_t)SEQ * 2 * DFF, 2 * DFF, seq, lds); }
    else if constexpr (ST == ST_FFNCONV) stage_ffn_conv(p, l);
    else if constexpr (ST == ST_GEMM_DOWN) { EpiResid E; E.p = p; E.row_base = seq * LP; E.ln_g = p.in[I_LN1G] + (size_t)l * DM; E.ln_b = p.in[I_LN1B] + (size_t)l * DM;
        stage_gemm(lds, (const bf16_t*)(p.ws + OFF_ACT), (const bf16_t*)(p.ws + OFF_WDOWN), SEQ, DM, DFF, E);
        tail_gemm<true>(p, (const bf16_t*)(p.ws + OFF_ACT) + (size_t)SEQ * DFF, (const bf16_t*)(p.ws + OFF_WDOWN), DM, DFF, nullptr, 0, seq, lds, E.ln_g, E.ln_b); }
    else if constexpr (ST == ST_LN2) stage_ln(p, l, 1);
}
template <int ST> __global__ void __launch_bounds__(NT, 2) k_stage(Params p, int l, int seq) {
    DYN_LDS(lds);
    run_stage<ST>(p, l, seq, lds);
}


constexpr int LDS_XB = LDS_BYTES - 16;
template <int S> __device__ __forceinline__ void seq_mixers(const Params& p, int l, LAS unsigned char* lds, const XcdBarrier& bar) {
    if constexpr (S < NSEQ) {
        xcd_barrier(bar); run_stage<ST_GEMM_IN>(p, l, S, lds);
#ifdef PROBE_GEMM2
        xcd_barrier(bar); run_stage<ST_GEMM_IN>(p, l, S, lds);
#endif
        xcd_barrier(bar); run_stage<ST_PREP>(p, l, S, lds);
#ifdef PROBE_PREP2
        xcd_barrier(bar); stage_prep(p, l, S, lds, DEPTH * NSEQ);
#endif
        xcd_barrier(bar); run_stage<ST_MIX>(p, l, S, lds);
#ifdef PROBE_MIX2
        xcd_barrier(bar); stage_mix(p, l, S, lds, DEPTH * NSEQ, PROBE_MIX2);
#endif
        xcd_barrier(bar); run_stage<ST_MIXFIN>(p, l, S, lds);
        seq_mixers<S + 1>(p, l, lds, bar);
    }
}
template <int S> __device__ __forceinline__ void seq_ffn(const Params& p, int l, LAS unsigned char* lds, const XcdBarrier& bar) {
    if constexpr (S < NSEQ) {
        xcd_barrier(bar); run_stage<ST_GEMM_UP>(p, l, S, lds);
#ifdef PROBE_GEMM2
        xcd_barrier(bar); run_stage<ST_GEMM_UP>(p, l, S, lds);
#endif
        xcd_barrier(bar); run_stage<ST_FFNCONV>(p, l, S, lds);
        xcd_barrier(bar); run_stage<ST_GEMM_DOWN>(p, l, S, lds);
        seq_ffn<S + 1>(p, l, lds, bar);
    }
}
template <int LL> __device__ __forceinline__ void layer_body(const Params& p, LAS unsigned char* lds, const XcdBarrier& bar) {
    if constexpr (LL < DEPTH) {
        xcd_barrier(bar); run_stage<ST_HYF_FIN>(p, LL, 0, lds);
        seq_mixers<0>(p, LL, lds, bar);
        xcd_barrier(bar); run_stage<ST_GEMM_OUT>(p, LL, 0, lds);
        xcd_barrier(bar); run_stage<ST_LN1>(p, LL, 0, lds);
        seq_ffn<0>(p, LL, lds, bar);
        xcd_barrier(bar); run_stage<ST_LN2>(p, LL, 0, lds);
        if constexpr (LL + 1 < DEPTH) { run_stage<ST_CONVERT>(p, LL + 1, 0, lds); run_stage<ST_HYF_RAW>(p, LL + 1, 0, lds); }
        layer_body<LL + 1>(p, lds, bar);
    }
}
__global__ void __launch_bounds__(NT, 2) k_mega(Params p) {
    DYN_LDS(lds);
    if (threadIdx.x == 0) *(LAS u32x4*)(lds + LDS_XB) = (u32x4){0u, 0u, 0u, 0u};
    __syncthreads();
    XcdBarrier bar = xcd_barrier_post((unsigned*)(p.ws + OFF_CTL), (volatile LAS unsigned*)(lds + LDS_XB));
    run_stage<ST_ROPE>(p, 0, 0, lds); run_stage<ST_EMBED>(p, 0, 0, lds);
    run_stage<ST_CONVERT>(p, 0, 0, lds); run_stage<ST_HYF_RAW>(p, 0, 0, lds);
    layer_body<0>(p, lds, bar);
}

static int g_grid = 0;
extern "C" void kernel_launch(void* const* d_in, const int* in_sizes, int n_in, void* d_out, int out_size, void* d_ws, size_t ws_size, hipStream_t stream) {
    (void)in_sizes; (void)out_size;
    if (n_in != N_IN || ws_size < WS_NEED) { fprintf(stderr, "kernel_launch: bad inputs (n_in %d, ws %zu < %zu)\n", n_in, ws_size, (size_t)WS_NEED); return; }
    if (!g_grid) { int dev = 0, cus = 0, per_cu = 0; hipGetDevice(&dev); hipDeviceGetAttribute(&cus, hipDeviceAttributeMultiprocessorCount, dev);
        if (hipFuncSetAttribute((const void*)k_mega, hipFuncAttributeMaxDynamicSharedMemorySize, LDS_BYTES) != hipSuccess) { fprintf(stderr, "kernel_launch: hipFuncSetAttribute failed\n"); return; }
        if (hipOccupancyMaxActiveBlocksPerMultiprocessor(&per_cu, (const void*)k_mega, NT, LDS_BYTES) != hipSuccess || per_cu < 1) { fprintf(stderr, "kernel_launch: occupancy query failed (%d)\n", per_cu); return; }
        g_grid = cus > 0 ? cus : 256; }
    Params p{};
    for (int i = 0; i < N_IN; ++i) p.in[i] = (const float*)d_in[i];
    p.out = (float*)d_out; p.ws = (unsigned char*)d_ws;
    hipMemsetAsync((unsigned char*)d_ws + OFF_CTL, 0, CTL_ZERO_BYTES, stream);
    LAUNCH(k_mega, dim3(g_grid), dim3(NT), LDS_BYTES, stream, p);
}
```
